# Optimizing an MI355X kernel written in HIP

```python
import jax
import jax.numpy as jnp
from jax import lax
import numpy as np

D_MODEL = 1024
BATCH = 16
SEQ = 2048
DEPTH = 1

GRID_W = 64
CTX_LEN = 256
HY_WIDTH = 512
HY_BANDS = 16
HY_EMB = 1 + 2 * HY_BANDS
HY_FILT_HIDDEN = 64
HY_DECAY_MIN = 2.0
HY_DECAY_MAX = 20.0
GLA_HEADS = 4
GLA_DK = 64
GLA_DV = 128
GLA_LOWRANK = 16
GLA_TAU = 16.0
GLA_CHUNK = 64
FFN_HIDDEN = 2816
EPS = 1e-6

HY_COLS = 3 * HY_WIDTH
GLA_QK = GLA_HEADS * GLA_DK
GLA_VW = GLA_HEADS * GLA_DV
IN_SIZES = (HY_COLS, GLA_QK, GLA_QK, GLA_VW, GLA_VW, GLA_LOWRANK, GLA_LOWRANK, D_MODEL, D_MODEL)
IN_COLS = HY_COLS + 2 * GLA_QK + 2 * GLA_VW + 2 * GLA_LOWRANK + 2 * D_MODEL

kernel_name = "hyena_gla_convffn_prefix_block"


def rmsnorm(x, w):
    xf = x.astype(jnp.float32)
    y = xf * lax.rsqrt(jnp.mean(xf * xf, axis=-1, keepdims=True) + EPS)
    return (y * w.astype(jnp.float32)).astype(x.dtype)


def adaln_params(cond, w_ada, b_ada):
    mod = jax.nn.silu(cond) @ w_ada + b_ada
    return jnp.split(mod, 6, axis=-1)


def split_in(proj):
    idx = np.cumsum(np.array(IN_SIZES))[:-1].tolist()
    return jnp.split(proj, idx, axis=-1)


def flip_t(t):
    return jnp.flip(t, axis=1)


def short_conv(u, w):
    L = u.shape[1]
    up = jnp.pad(u, ((0, 0), (1, 1), (0, 0)))
    return up[:, :L] * w[0] + up[:, 1:L + 1] * w[1] + up[:, 2:] * w[2]


def hyena_filter(L, p):
    f32 = jnp.float32
    t = jnp.linspace(0.0, 1.0, L, dtype=f32)[:, None]
    w = (2.0 * np.pi / L) * jnp.arange(L, dtype=f32)[:, None]
    f = jnp.linspace(1e-4, HY_BANDS - 1, HY_BANDS, dtype=f32)[None, :]
    feats = jnp.concatenate([t, jnp.cos(f * w), -jnp.sin(f * w)], axis=-1)
    freq = p["hy_filt_freq"].astype(f32)
    hdn = jnp.sin(freq * (feats @ p["hy_filt_w1"].astype(f32) + p["hy_filt_b1"].astype(f32)))
    hdn = jnp.sin(freq * (hdn @ p["hy_filt_w2"].astype(f32) + p["hy_filt_b2"].astype(f32)))
    k = (hdn @ p["hy_filt_w3"].astype(f32)) * jnp.exp(-t * p["hy_decay"].astype(f32))
    k_fwd = k[:, :HY_WIDTH]
    k_bwd = jnp.flip(k[1:, HY_WIDTH:], axis=0)
    norm = jnp.sum(jnp.abs(k_fwd), axis=0) + jnp.sum(jnp.abs(k_bwd), axis=0)
    kbuf = jnp.concatenate([k_fwd, jnp.zeros((1, HY_WIDTH), f32), k_bwd], axis=0)
    return kbuf / norm


def hyena_branch(u, p):
    L = u.shape[1]
    u = short_conv(u, p["hy_conv_w"])
    x0, x1, v = jnp.split(u, 3, axis=-1)
    z = (x1 * v).astype(jnp.float32)
    kbuf = hyena_filter(L, p)
    zf = jnp.fft.rfft(z, n=2 * L, axis=1)
    kf = jnp.fft.rfft(kbuf, n=2 * L, axis=0)
    y = jnp.fft.irfft(zf * kf[None], n=2 * L, axis=1)[:, :L]
    y = y + p["hy_bias"].astype(jnp.float32) * z
    return (x0.astype(jnp.float32) * y).astype(u.dtype)


def heads(t, d):
    return t.astype(jnp.float32).reshape(t.shape[0], t.shape[1], GLA_HEADS, d)


def log_decay(a, w_up, bias):
    la = jax.nn.log_sigmoid(a.astype(jnp.float32) @ w_up.astype(jnp.float32) + bias.astype(jnp.float32))
    return heads(la, GLA_DK) / GLA_TAU


def gla_chunked(q, k, v, log_a, s0):
    B, L, H, _ = q.shape
    N = L // GLA_CHUNK
    rs = lambda t: t.reshape(B, N, GLA_CHUNK, H, t.shape[-1])
    q, k, v, log_a = rs(q), rs(k), rs(v), rs(log_a)
    b = jnp.cumsum(log_a, axis=2)
    b_last = b[:, :, -1:]
    qe = q * jnp.exp(b)
    ke = k * jnp.exp(-b)
    kd = k * jnp.exp(b_last - b)
    mask = jnp.tril(jnp.ones((GLA_CHUNK, GLA_CHUNK), dtype=bool))
    scores = jnp.where(mask, jnp.einsum("bnchd,bnshd->bnhcs", qe, ke), 0.0)
    intra = jnp.einsum("bnhcs,bnshv->bnchv", scores, v)
    upd = jnp.einsum("bnshd,bnshv->bnhdv", kd, v)
    g = jnp.exp(b_last[:, :, 0])

    def step(s, xs):
        gn, un = xs
        return gn[..., None] * s + un, s

    _, s_prev = lax.scan(step, s0, (jnp.moveaxis(g, 1, 0), jnp.moveaxis(upd, 1, 0)))
    s_prev = jnp.moveaxis(s_prev, 0, 1)
    inter = jnp.einsum("bnchd,bnhdv->bnchv", qe, s_prev)
    return (intra + inter).reshape(B, L, H, v.shape[-1])


def gla_final_state(k, v, log_a):
    b = jnp.cumsum(log_a, axis=1)
    return jnp.einsum("blhd,blhv->bhdv", k * jnp.exp(b[:, -1:] - b), v)


def mixer(proj, p, s_f0, s_b0):
    u_hy, q, k, v, r, a_f, a_b, g_hy, g_gla = split_in(proj)
    y_hy = hyena_branch(u_hy, p)
    q = heads(q, GLA_DK) * (GLA_DK ** -0.5)
    k = heads(k, GLA_DK)
    v = heads(v, GLA_DV)
    la_f = log_decay(a_f, p["gla_a_up_f"], p["gla_a_bias_f"])
    la_b = log_decay(a_b, p["gla_a_up_b"], p["gla_a_bias_b"])
    o_f = gla_chunked(q, k, v, la_f, s_f0)
    o_b = flip_t(gla_chunked(flip_t(q), flip_t(k), flip_t(v), flip_t(la_b), s_b0))
    o = o_f + o_b
    o = o * lax.rsqrt(jnp.mean(o * o, axis=-1, keepdims=True) + EPS)
    B, L = o.shape[0], o.shape[1]
    y_gla = (o.reshape(B, L, GLA_VW) * p["gla_norm_w"].astype(jnp.float32)
             * jax.nn.silu(r.astype(jnp.float32))).astype(proj.dtype)
    merged = (jax.nn.sigmoid(g_hy) * (y_hy @ p["w_hy_proj"])
              + jax.nn.sigmoid(g_gla) * (y_gla @ p["w_gla_proj"]))
    return merged @ p["w_out"]


def conv_ffn(h, p, grid_w):
    B, L, _ = h.shape
    rows = L // grid_w
    up, gate = jnp.split(h @ p["ffn_w_in"], 2, axis=-1)
    g = gate.reshape(B, rows, grid_w, FFN_HIDDEN)
    g = lax.conv_general_dilated(g, p["ffn_dw"][:, :, None, :], window_strides=(1, 1), padding="SAME",
                                 dimension_numbers=("NHWC", "HWIO", "NHWC"),
                                 feature_group_count=FFN_HIDDEN)
    g = g.reshape(B, L, FFN_HIDDEN) + p["ffn_dw_bias"]
    return (jax.nn.silu(g) * up) @ p["ffn_w_out"]


def layer(x, ctx, c, c_ctx, p, update_ctx):
    sh1, sc1, g1, sh2, sc2, g2 = adaln_params(c[:, None, :], p["w_ada"], p["b_ada"])
    csh1, csc1, cg1, csh2, csc2, cg2 = adaln_params(c_ctx, p["w_ada"], p["b_ada"])
    hc = rmsnorm(ctx, p["norm1_w"]) * (1.0 + csc1) + csh1
    pc = hc @ p["w_in"]
    _, _, kc, vc, _, ac_f, ac_b, _, _ = split_in(pc)
    kc = heads(kc, GLA_DK)
    vc = heads(vc, GLA_DV)
    s_f = gla_final_state(kc, vc, log_decay(ac_f, p["gla_a_up_f"], p["gla_a_bias_f"]))
    s_b = gla_final_state(flip_t(kc), flip_t(vc),
                          flip_t(log_decay(ac_b, p["gla_a_up_b"], p["gla_a_bias_b"])))
    hx = rmsnorm(x, p["norm1_w"]) * (1.0 + sc1) + sh1
    x_new = x + g1 * mixer(hx @ p["w_in"], p, s_f, s_b)
    x_new = x_new + g2 * conv_ffn(rmsnorm(x_new, p["norm2_w"]) * (1.0 + sc2) + sh2, p, GRID_W)
    if update_ctx:
        z0 = jnp.zeros_like(s_f)
        ctx = ctx + cg1 * mixer(pc, p, z0, z0)
        ctx = ctx + cg2 * conv_ffn(rmsnorm(ctx, p["norm2_w"]) * (1.0 + csc2) + csh2, p, ctx.shape[1])
    return x_new, ctx


def setup_inputs(seed: int = 0) -> dict:
    key = jax.random.key(seed)
    ks = jax.random.split(key, 32)
    f32 = jnp.float32
    nrm = lambda k, shape, s: jax.random.normal(k, shape, f32) * s
    L_ = DEPTH
    return {
        "x": nrm(ks[0], (BATCH, SEQ, D_MODEL), 1.0),
        "c": nrm(ks[1], (BATCH, D_MODEL), 1.0),
        "ctx": nrm(ks[2], (BATCH, CTX_LEN, D_MODEL), 1.0),
        "c_ctx": nrm(ks[3], (D_MODEL,), 1.0),
        "w_ada": nrm(ks[4], (L_, D_MODEL, 6 * D_MODEL), 0.5 * D_MODEL ** -0.5),
        "b_ada": nrm(ks[5], (L_, 6 * D_MODEL), 0.02),
        "norm1_w": 1.0 + nrm(ks[6], (L_, D_MODEL), 0.02),
        "norm2_w": 1.0 + nrm(ks[7], (L_, D_MODEL), 0.02),
        "w_in": nrm(ks[8], (L_, D_MODEL, IN_COLS), D_MODEL ** -0.5),
        "hy_conv_w": nrm(ks[9], (L_, 3, HY_COLS), 3 ** -0.5),
        "hy_filt_w1": nrm(ks[10], (L_, HY_EMB, HY_FILT_HIDDEN), HY_EMB ** -0.5),
        "hy_filt_b1": nrm(ks[11], (L_, HY_FILT_HIDDEN), 0.1),
        "hy_filt_w2": nrm(ks[12], (L_, HY_FILT_HIDDEN, HY_FILT_HIDDEN), HY_FILT_HIDDEN ** -0.5),
        "hy_filt_b2": nrm(ks[13], (L_, HY_FILT_HIDDEN), 0.1),
        "hy_filt_w3": nrm(ks[14], (L_, HY_FILT_HIDDEN, 2 * HY_WIDTH), HY_FILT_HIDDEN ** -0.5),
        "hy_filt_freq": 1.0 + nrm(ks[15], (L_, HY_FILT_HIDDEN), 0.1),
        "hy_decay": jax.random.uniform(ks[16], (L_, 2 * HY_WIDTH), f32, HY_DECAY_MIN, HY_DECAY_MAX),
        "hy_bias": nrm(ks[17], (L_, HY_WIDTH), 0.5),
        "gla_a_up_f": nrm(ks[18], (L_, GLA_LOWRANK, GLA_QK), GLA_LOWRANK ** -0.5),
        "gla_a_bias_f": nrm(ks[19], (L_, GLA_QK), 0.5),
        "gla_a_up_b": nrm(ks[20], (L_, GLA_LOWRANK, GLA_QK), GLA_LOWRANK ** -0.5),
        "gla_a_bias_b": nrm(ks[21], (L_, GLA_QK), 0.5),
        "gla_norm_w": 1.0 + nrm(ks[22], (L_, GLA_VW), 0.02),
        "w_hy_proj": nrm(ks[23], (L_, HY_WIDTH, D_MODEL), HY_WIDTH ** -0.5),
        "w_gla_proj": nrm(ks[24], (L_, GLA_VW, D_MODEL), GLA_VW ** -0.5),
        "w_out": nrm(ks[25], (L_, D_MODEL, D_MODEL), D_MODEL ** -0.5),
        "ffn_w_in": nrm(ks[26], (L_, D_MODEL, 2 * FFN_HIDDEN), D_MODEL ** -0.5),
        "ffn_dw": nrm(ks[27], (L_, 3, 3, FFN_HIDDEN), 1.0 / 3.0),
        "ffn_dw_bias": nrm(ks[28], (L_, FFN_HIDDEN), 0.02),
        "ffn_w_out": nrm(ks[29], (L_, FFN_HIDDEN, D_MODEL), FFN_HIDDEN ** -0.5),
        "final_norm_w": 1.0 + nrm(ks[30], (D_MODEL,), 0.02),
    }


def reference(x, c, ctx, c_ctx, w_ada, b_ada, norm1_w, norm2_w, w_in, hy_conv_w,
              hy_filt_w1, hy_filt_b1, hy_filt_w2, hy_filt_b2, hy_filt_w3, hy_filt_freq,
              hy_decay, hy_bias, gla_a_up_f, gla_a_bias_f, gla_a_up_b, gla_a_bias_b,
              gla_norm_w, w_hy_proj, w_gla_proj, w_out, ffn_w_in, ffn_dw, ffn_dw_bias,
              ffn_w_out, final_norm_w):
    for l in range(DEPTH):
        p = {
            "w_ada": w_ada[l], "b_ada": b_ada[l], "norm1_w": norm1_w[l], "norm2_w": norm2_w[l],
            "w_in": w_in[l], "hy_conv_w": hy_conv_w[l],
            "hy_filt_w1": hy_filt_w1[l], "hy_filt_b1": hy_filt_b1[l],
            "hy_filt_w2": hy_filt_w2[l], "hy_filt_b2": hy_filt_b2[l],
            "hy_filt_w3": hy_filt_w3[l], "hy_filt_freq": hy_filt_freq[l],
            "hy_decay": hy_decay[l], "hy_bias": hy_bias[l],
            "gla_a_up_f": gla_a_up_f[l], "gla_a_bias_f": gla_a_bias_f[l],
            "gla_a_up_b": gla_a_up_b[l], "gla_a_bias_b": gla_a_bias_b[l],
            "gla_norm_w": gla_norm_w[l], "w_hy_proj": w_hy_proj[l], "w_gla_proj": w_gla_proj[l],
            "w_out": w_out[l], "ffn_w_in": ffn_w_in[l], "ffn_dw": ffn_dw[l],
            "ffn_dw_bias": ffn_dw_bias[l], "ffn_w_out": ffn_w_out[l],
        }
        x, ctx = layer(x, ctx, c, c_ctx, p, l < DEPTH - 1)
    return rmsnorm(x, final_norm_w)
```

```cpp
#include <hip/hip_runtime.h>
#include <hip/hip_cooperative_groups.h>
#include <cstdio>
#include <cstdint>
namespace cg = cooperative_groups;
namespace pg8 {
#define PG8_LAS __attribute__((address_space(3)))
typedef unsigned short bf16_t;
typedef short bf16x8 __attribute__((ext_vector_type(8)));
typedef float f32x4 __attribute__((ext_vector_type(4)));
typedef unsigned u32x4 __attribute__((ext_vector_type(4)));
typedef unsigned u32x2 __attribute__((ext_vector_type(2)));
constexpr int BM = 256, BK = 64, HALF = 128, HTB = HALF * BK * 2  , STAGE_BYTES = 8 * HTB, NXCD = 8, WGM = 8;

__host__ __device__ __forceinline__ int lds_byte(int r, int c) { const int st = (r >> 4) * 2 + (c >> 5), rr = r & 15, cc = c & 31, ob = rr * 64 + cc * 2; return st * 1024 + (ob ^ (((ob >> 9) & 1) << 5)); }
__host__ __device__ __forceinline__ void stage_rc(int b, int& R, int& C) { const int st = b / 1024, sb = b % 1024, swz = sb ^ (((sb >> 9) & 1) << 5); R = (st >> 1) * 16 + swz / 64; C = (st & 1) * 32 + (swz % 64) / 2; }
__host__ __device__ __forceinline__ int perm32(int rho) { const int n = rho >> 4, i = rho & 15; return 8 * (i >> 2) + 4 * n + (i & 3); }

struct Unit { int pm, pn; };
struct Gemm { const bf16_t* A; const bf16_t* Bt; int M, N, K; };

struct StaticOrder {
    int nM, nN, nwg, G, c;
    __host__ __device__ void init(int M, int N, int G_, int c_) { nM = M / BM; nN = N / BM; nwg = nM * nN; G = G_; c = c_; }
    __host__ __device__ bool next(int i, Unit& u) const {
        const long L = (long)i * G + c; if (L >= nwg) return false;
        int wgid = (int)L; { const int q = nwg / NXCD, r = nwg % NXCD, xcd = wgid % NXCD, off = wgid / NXCD; wgid = (xcd < r ? xcd * (q + 1) : r * (q + 1) + (xcd - r) * q) + off; }
        const int nig = WGM * nN, gid = wgid / nig, fm = gid * WGM, gsz = (nM - fm) < WGM ? (nM - fm) : WGM;
        u.pm = fm + ((wgid % nig) % gsz); u.pn = (wgid % nig) / gsz; return true;
    }
    __device__ __forceinline__ void a_ready(const Unit&) const {}
    __device__ __forceinline__ void done(const Unit&) const {}
};

__device__ __forceinline__ unsigned cvt_pk_bf16(float lo, float hi) { unsigned r; asm volatile("v_cvt_pk_bf16_f32 %0, %1, %2" : "=v"(r) : "v"(lo), "v"(hi)); return r; }
typedef float f32x2 __attribute__((ext_vector_type(2)));
__device__ __forceinline__ f32x2 gelu_pk(f32x2 v) {
    const f32x2 av = __builtin_elementwise_abs(v), d = av * 0.2316418882f + 1.0f;
    f32x2 t; t.x = __builtin_amdgcn_rcpf(d.x); t.y = __builtin_amdgcn_rcpf(d.y);
    f32x2 q = t * 0.5307027145f + (-0.7265760135f); q = q * t + 0.7107068705f; q = q * t + (-0.142248368f); q = q * t + 0.127414796f; q = q * t;
    const f32x2 s = (v * v) * (-0.72134752044f);
    f32x2 e; e.x = __builtin_amdgcn_exp2f(s.x); e.y = __builtin_amdgcn_exp2f(s.y);
    const f32x2 m = v * (q * e), r = v - m;
    f32x2 o; o.x = v.x < 0.f ? m.x : r.x; o.y = v.y < 0.f ? m.y : r.y; return o;
}

template <int ACT  > struct EpiBf16 {
    static constexpr bool PERM = true, AFTER_DRAIN = false; static constexpr int MIDK = 0; static_assert(ACT == 0 || ACT == 1, "EpiBf16: ACT is 0 (none) or 1 (gelu_pk)");
    bf16_t* O; int ldc; const float* bias; int split_cols; size_t split_stride; float scale0;
    __device__ __forceinline__ void operator()(const f32x4 (&acc)[2][2][4][2], const Unit& u, int wr, int wc, int fr, int fq) const {
        const int row0 = u.pm * BM + wr * 64 + fr; int colt = u.pn * BM; bf16_t* base = O;
        float sc = 1.f; if (split_cols) { const int t = colt / split_cols; base += (size_t)t * split_stride; colt -= t * split_cols; if (t == 0) sc = scale0; }
        const int col0 = colt + wc * 32 + 8 * fq, bcol0 = u.pn * BM + wc * 32 + 8 * fq;
        f32x4 bv[2][2];
#pragma unroll
        for (int bj = 0; bj < 2; ++bj)
#pragma unroll
            for (int n = 0; n < 2; ++n) bv[bj][n] = bias ? *(const f32x4*)(bias + bcol0 + bj * HALF + 4 * n) : (f32x4){0.f, 0.f, 0.f, 0.f};
#pragma unroll
        for (int ai = 0; ai < 2; ++ai)
#pragma unroll
            for (int m = 0; m < 4; ++m) { bf16_t* rowp = base + (size_t)(row0 + ai * HALF + m * 16) * ldc + col0;
#pragma unroll
                for (int bj = 0; bj < 2; ++bj) { f32x4 v0 = acc[ai][bj][m][0] + bv[bj][0], v1 = acc[ai][bj][m][1] + bv[bj][1];
                    if (ACT == 1) { f32x2 a = gelu_pk((f32x2){v0[0], v0[1]}), b = gelu_pk((f32x2){v0[2], v0[3]}), c = gelu_pk((f32x2){v1[0], v1[1]}), d = gelu_pk((f32x2){v1[2], v1[3]});
                        v0 = (f32x4){a.x, a.y, b.x, b.y}; v1 = (f32x4){c.x, c.y, d.x, d.y}; }
                    v0 = v0 * sc; v1 = v1 * sc; u32x4 w; w.x = cvt_pk_bf16(v0[0], v0[1]); w.y = cvt_pk_bf16(v0[2], v0[3]); w.z = cvt_pk_bf16(v1[0], v1[1]); w.w = cvt_pk_bf16(v1[2], v1[3]);
                    *(u32x4*)(rowp + bj * HALF) = w; } }
    }
};
struct ProjOrder {
    StaticOrder so; int G, c;
    __host__ __device__ void init(int G_, int c_) { so.init(32768, 5376, G_, c_); G = G_; c = c_; }
    __host__ __device__ bool next(int i, Unit& u) const {
        const long L = (long)i * G + c;
        if (L < so.nwg) return so.next(i, u);
        const int j = (int)(L - so.nwg); if (j >= 64) return false;
        u.pm = 128 + (j >> 2); u.pn = j & 3; return true;
    }
    __device__ __forceinline__ void a_ready(const Unit&) const {}
    __device__ __forceinline__ void done(const Unit&) const {}
};
__device__ __forceinline__ float bflo(unsigned w) { return __uint_as_float(w << 16); }
__device__ __forceinline__ float bfhi(unsigned w) { return __uint_as_float(w & 0xffff0000u); }
__device__ __forceinline__ float sigm(float x) { return 1.0f / (1.0f + __expf(-x)); }

struct EpiProj {
    static constexpr bool PERM = true, AFTER_DRAIN = false; static constexpr int MIDK = 0;
    bf16_t *kva, *hy, *qr, *gates;
    __device__ __forceinline__ void operator()(const f32x4 (&acc)[2][2][4][2], const Unit& u, int wr, int wc, int fr, int fq) const {
        bf16_t* base; int ldc, colt; const int pn = u.pn;
        if (pn < 4) { base = kva; ldc = 1024; colt = pn * 256; }
        else if (pn < 10) {
            const int c0t = (pn - 4) * 256 + wc * 32 + 8 * fq, lanebase = (fq << 4) + ((fr & 3) << 2), msel = fr >> 2;
#pragma unroll
            for (int ai = 0; ai < 2; ++ai) { const int tok = u.pm * BM + ai * HALF + wr * 64 + 4 * fr;
#pragma unroll
                for (int bj = 0; bj < 2; ++bj) {
                    unsigned W[4][4];
#pragma unroll
                    for (int m = 0; m < 4; ++m) { const f32x4 v0 = acc[ai][bj][m][0], v1 = acc[ai][bj][m][1];
                        W[m][0] = cvt_pk_bf16(v0[0], v0[1]); W[m][1] = cvt_pk_bf16(v0[2], v0[3]); W[m][2] = cvt_pk_bf16(v1[0], v1[1]); W[m][3] = cvt_pk_bf16(v1[2], v1[3]); }
#pragma unroll
                    for (int k = 0; k < 4; ++k) { unsigned T[4];
#pragma unroll
                        for (int s = 0; s < 4; ++s) { const int src = lanebase + s;
                            const unsigned g0 = (unsigned)__shfl((int)W[0][k], src), g1 = (unsigned)__shfl((int)W[1][k], src), g2 = (unsigned)__shfl((int)W[2][k], src), g3 = (unsigned)__shfl((int)W[3][k], src);
                            T[s] = msel == 0 ? g0 : (msel == 1 ? g1 : (msel == 2 ? g2 : g3)); }
                        u32x2 lo, hi; lo.x = (T[0] & 0xffffu) | (T[1] << 16); lo.y = (T[2] & 0xffffu) | (T[3] << 16); hi.x = (T[0] >> 16) | (T[1] & 0xffff0000u); hi.y = (T[2] >> 16) | (T[3] & 0xffff0000u);
                        bf16_t* cp = hy + (size_t)(c0t + bj * HALF + 2 * k) * 32768 + tok;
                        *(u32x2*)cp = lo; *(u32x2*)(cp + 32768) = hi; } } }
            return; }
        else if (pn < 13) { base = qr; ldc = 768; colt = (pn - 10) * 256; }
        else { base = gates; ldc = 2048; colt = (pn - 13) * 256; }
        const int row0 = u.pm * BM + wr * 64 + fr, col0 = colt + wc * 32 + 8 * fq;
#pragma unroll
        for (int ai = 0; ai < 2; ++ai)
#pragma unroll
            for (int m = 0; m < 4; ++m) { bf16_t* rowp = base + (size_t)(row0 + ai * HALF + m * 16) * ldc + col0;
#pragma unroll
                for (int bj = 0; bj < 2; ++bj) { const f32x4 v0 = acc[ai][bj][m][0], v1 = acc[ai][bj][m][1];
                    u32x4 w; w.x = cvt_pk_bf16(v0[0], v0[1]); w.y = cvt_pk_bf16(v0[2], v0[3]); w.z = cvt_pk_bf16(v1[0], v1[1]); w.w = cvt_pk_bf16(v1[2], v1[3]);
                    *(u32x4*)(rowp + bj * HALF) = w; } }
    }
};
struct EpiSplit {
    static constexpr bool PERM = true, AFTER_DRAIN = false; static constexpr int MIDK = 0;
    bf16_t *o0, *o1; int nsplit, ldc;
    __device__ __forceinline__ void operator()(const f32x4 (&acc)[2][2][4][2], const Unit& u, int wr, int wc, int fr, int fq) const {
        bf16_t* base = u.pn < nsplit ? o0 : o1; const int colt = (u.pn < nsplit ? u.pn : u.pn - nsplit) * 256;
        const int row0 = u.pm * BM + wr * 64 + fr, col0 = colt + wc * 32 + 8 * fq;
#pragma unroll
        for (int ai = 0; ai < 2; ++ai)
#pragma unroll
            for (int m = 0; m < 4; ++m) { bf16_t* rowp = base + (size_t)(row0 + ai * HALF + m * 16) * ldc + col0;
#pragma unroll
                for (int bj = 0; bj < 2; ++bj) { const f32x4 v0 = acc[ai][bj][m][0], v1 = acc[ai][bj][m][1];
                    u32x4 w; w.x = cvt_pk_bf16(v0[0], v0[1]); w.y = cvt_pk_bf16(v0[2], v0[3]); w.z = cvt_pk_bf16(v1[0], v1[1]); w.w = cvt_pk_bf16(v1[2], v1[3]);
                    *(u32x4*)(rowp + bj * HALF) = w; } }
    }
};
template <int SECOND> struct EpiGate {
    static constexpr bool PERM = true, AFTER_DRAIN = false; static constexpr int MIDK = 0;
    const bf16_t* gates; bf16_t* merged;
    __device__ __forceinline__ void operator()(const f32x4 (&acc)[2][2][4][2], const Unit& u, int wr, int wc, int fr, int fq) const {
        const int row0 = u.pm * BM + wr * 64 + fr, col0 = u.pn * BM + wc * 32 + 8 * fq;
#pragma unroll
        for (int ai = 0; ai < 2; ++ai)
#pragma unroll
            for (int m = 0; m < 4; ++m) { const size_t row = (size_t)(row0 + ai * HALF + m * 16);
#pragma unroll
                for (int bj = 0; bj < 2; ++bj) { const int col = col0 + bj * HALF;
                    const u32x4 g = *(const u32x4*)(gates + row * 2048 + SECOND * 1024 + col);
                    const f32x4 a0 = acc[ai][bj][m][0], a1 = acc[ai][bj][m][1];
                    float v[8];
                    v[0] = sigm(bflo(g.x)) * a0[0]; v[1] = sigm(bfhi(g.x)) * a0[1]; v[2] = sigm(bflo(g.y)) * a0[2]; v[3] = sigm(bfhi(g.y)) * a0[3];
                    v[4] = sigm(bflo(g.z)) * a1[0]; v[5] = sigm(bfhi(g.z)) * a1[1]; v[6] = sigm(bflo(g.w)) * a1[2]; v[7] = sigm(bfhi(g.w)) * a1[3];
                    bf16_t* mp = merged + row * 1024 + col;
                    if (SECOND) { const u32x4 p = *(const u32x4*)mp;
                        v[0] += bflo(p.x); v[1] += bfhi(p.x); v[2] += bflo(p.y); v[3] += bfhi(p.y); v[4] += bflo(p.z); v[5] += bfhi(p.z); v[6] += bflo(p.w); v[7] += bfhi(p.w); }
                    u32x4 w; w.x = cvt_pk_bf16(v[0], v[1]); w.y = cvt_pk_bf16(v[2], v[3]); w.z = cvt_pk_bf16(v[4], v[5]); w.w = cvt_pk_bf16(v[6], v[7]);
                    *(u32x4*)mp = w; } }
    }
};
struct EpiRes {
    static constexpr bool PERM = true, AFTER_DRAIN = false; static constexpr int MIDK = 0;
    const float* base; float* out; const float* gate;
    __device__ __forceinline__ void operator()(const f32x4 (&acc)[2][2][4][2], const Unit& u, int wr, int wc, int fr, int fq) const {
        const int row0 = u.pm * BM + wr * 64 + fr, col0 = u.pn * BM + wc * 32 + 8 * fq;
        const float* gp = gate + (size_t)(u.pm >> 3) * 6144 + col0;
        f32x4 gv[2][2];
#pragma unroll
        for (int bj = 0; bj < 2; ++bj)
#pragma unroll
            for (int n = 0; n < 2; ++n) gv[bj][n] = *(const f32x4*)(gp + bj * HALF + 4 * n);
#pragma unroll
        for (int ai = 0; ai < 2; ++ai)
#pragma unroll
            for (int m = 0; m < 4; ++m) { const size_t off = (size_t)(row0 + ai * HALF + m * 16) * 1024 + col0;
#pragma unroll
                for (int bj = 0; bj < 2; ++bj)
#pragma unroll
                    for (int n = 0; n < 2; ++n) { const f32x4 bs = *(const f32x4*)(base + off + bj * HALF + 4 * n);
                        *(f32x4*)(out + off + bj * HALF + 4 * n) = bs + gv[bj][n] * acc[ai][bj][m][n]; } }
    }
};

struct EpiGateFused {
    static constexpr bool PERM = true, AFTER_DRAIN = false; static constexpr int MIDK = 8;
    const bf16_t* gates; bf16_t* merged;
    __device__ __forceinline__ void mid(f32x4 (&acc)[2][2][4][2], const Unit& u, int wr, int wc, int fr, int fq) const {
        int row0 = u.pm * BM + wr * 64 + fr, col0 = u.pn * BM + wc * 32 + 8 * fq;
        asm volatile("" : "+v"(row0), "+v"(col0));
#pragma unroll
        for (int ai = 0; ai < 2; ++ai)
#pragma unroll
            for (int m = 0; m < 4; ++m) { const size_t row = (size_t)(row0 + ai * HALF + m * 16);
#pragma unroll
                for (int bj = 0; bj < 2; ++bj) { const int col = col0 + bj * HALF;
                    const u32x4 gh = *(const u32x4*)(gates + row * 2048 + col), gg = *(const u32x4*)(gates + row * 2048 + 1024 + col);
                    const float h[8] = {bflo(gh.x), bfhi(gh.x), bflo(gh.y), bfhi(gh.y), bflo(gh.z), bfhi(gh.z), bflo(gh.w), bfhi(gh.w)};
                    const float g[8] = {bflo(gg.x), bfhi(gg.x), bflo(gg.y), bfhi(gg.y), bflo(gg.z), bfhi(gg.z), bflo(gg.w), bfhi(gg.w)};
#pragma unroll
                    for (int j = 0; j < 8; ++j) { const float r = (1.0f + __expf(-g[j])) * __builtin_amdgcn_rcpf(1.0f + __expf(-h[j])); acc[ai][bj][m][j >> 2][j & 3] *= r; } }
                if (m == 3) asm volatile("" ::: "memory"); }
    }
    __device__ __forceinline__ void operator()(const f32x4 (&acc)[2][2][4][2], const Unit& u, int wr, int wc, int fr, int fq) const {
        const int row0 = u.pm * BM + wr * 64 + fr, col0 = u.pn * BM + wc * 32 + 8 * fq;
#pragma unroll
        for (int ai = 0; ai < 2; ++ai)
#pragma unroll
            for (int m = 0; m < 4; ++m) { const size_t row = (size_t)(row0 + ai * HALF + m * 16);
#pragma unroll
                for (int bj = 0; bj < 2; ++bj) { const int col = col0 + bj * HALF;
                    const u32x4 g = *(const u32x4*)(gates + row * 2048 + 1024 + col);
                    const f32x4 a0 = acc[ai][bj][m][0], a1 = acc[ai][bj][m][1];
                    u32x4 w; w.x = cvt_pk_bf16(sigm(bflo(g.x)) * a0[0], sigm(bfhi(g.x)) * a0[1]); w.y = cvt_pk_bf16(sigm(bflo(g.y)) * a0[2], sigm(bfhi(g.y)) * a0[3]);
                    w.z = cvt_pk_bf16(sigm(bflo(g.z)) * a1[0], sigm(bfhi(g.z)) * a1[1]); w.w = cvt_pk_bf16(sigm(bflo(g.w)) * a1[2], sigm(bfhi(g.w)) * a1[3]);
                    *(u32x4*)(merged + row * 1024 + col) = w; } }
    }
};

template <int MODE> struct EpiResNorm {
    static constexpr bool PERM = true, AFTER_DRAIN = false; static constexpr int MIDK = 0;
    const float* base; float* xout; const float* gate; float* rowss; unsigned* cnt; const float* nw; const float* mod; bf16_t* h2; unsigned* tmo;
    __device__ __forceinline__ void operator()(f32x4 (&acc)[2][2][4][2], const Unit& u, int wr, int wc, int fr, int fq) const {
        const int row0 = u.pm * BM + wr * 64 + fr, col0 = u.pn * BM + wc * 32 + 8 * fq, b = u.pm >> 3;
        {
            const float* gp = gate + (size_t)b * 6144 + col0;
            f32x4 gv[2][2];
#pragma unroll
            for (int bj = 0; bj < 2; ++bj)
#pragma unroll
                for (int n = 0; n < 2; ++n) gv[bj][n] = *(const f32x4*)(gp + bj * HALF + 4 * n);
#pragma unroll
            for (int ai = 0; ai < 2; ++ai)
#pragma unroll
                for (int m = 0; m < 4; ++m) { const float* bp = base + (size_t)(row0 + ai * HALF + m * 16) * 1024 + col0;
#pragma unroll
                    for (int bj = 0; bj < 2; ++bj)
#pragma unroll
                        for (int n = 0; n < 2; ++n) { const f32x4 bs = *(const f32x4*)(bp + bj * HALF + 4 * n); acc[ai][bj][m][n] = bs + gv[bj][n] * acc[ai][bj][m][n]; }
                    if (m == 3) asm volatile("" : "+v"(acc[ai][0][0][0]), "+v"(acc[ai][0][0][1]), "+v"(acc[ai][1][0][0]), "+v"(acc[ai][1][0][1]),
                                                  "+v"(acc[ai][0][1][0]), "+v"(acc[ai][0][1][1]), "+v"(acc[ai][1][1][0]), "+v"(acc[ai][1][1][1]),
                                                  "+v"(acc[ai][0][2][0]), "+v"(acc[ai][0][2][1]), "+v"(acc[ai][1][2][0]), "+v"(acc[ai][1][2][1]),
                                                  "+v"(acc[ai][0][3][0]), "+v"(acc[ai][0][3][1]), "+v"(acc[ai][1][3][0]), "+v"(acc[ai][1][3][1]) :: "memory"); }
        }
#pragma unroll
        for (int ai = 0; ai < 2; ++ai)
#pragma unroll
            for (int m = 0; m < 4; ++m) { float s = 0.f;
#pragma unroll
                for (int bj = 0; bj < 2; ++bj)
#pragma unroll
                    for (int n = 0; n < 2; ++n) { const f32x4 x = acc[ai][bj][m][n]; s += (x[0] * x[0] + x[1] * x[1]) + (x[2] * x[2] + x[3] * x[3]); }
                s += __shfl_xor(s, 16); s += __shfl_xor(s, 32);
                if (fq == 0) atomicAdd(rowss + row0 + ai * HALF + m * 16, s); }
        asm volatile("s_waitcnt vmcnt(0)" ::: "memory");
        __syncthreads();
        if (threadIdx.x == 0) {
            unsigned* c = cnt + 64 * u.pm;
            __hip_atomic_fetch_add(c, 1u, __ATOMIC_RELAXED, __HIP_MEMORY_SCOPE_AGENT);
            unsigned sp = 0;
            while (__hip_atomic_load(c, __ATOMIC_RELAXED, __HIP_MEMORY_SCOPE_AGENT) < 4u) { __builtin_amdgcn_s_sleep(2); if (++sp > (1u << 22)) { __hip_atomic_store(tmo, 1u, __ATOMIC_RELAXED, __HIP_MEMORY_SCOPE_AGENT); break; } }
            __builtin_amdgcn_fence(__ATOMIC_ACQUIRE, "agent");
            asm volatile("s_waitcnt vmcnt(0)" ::: "memory");
        }
        __syncthreads();
        float rstd[2][4];
#pragma unroll
        for (int ai = 0; ai < 2; ++ai)
#pragma unroll
            for (int m = 0; m < 4; ++m) { const float ss = __hip_atomic_load(rowss + row0 + ai * HALF + m * 16, __ATOMIC_RELAXED, __HIP_MEMORY_SCOPE_AGENT); rstd[ai][m] = rsqrtf(ss * (1.0f / 1024.0f) + 1e-6f); }
        {
            f32x4 scl[2][2], sft[2][2];
#pragma unroll
            for (int bj = 0; bj < 2; ++bj)
#pragma unroll
                for (int n = 0; n < 2; ++n) { const int col = col0 + bj * HALF + 4 * n; scl[bj][n] = *(const f32x4*)(nw + col); sft[bj][n] = (f32x4){0.f, 0.f, 0.f, 0.f};
                    if (MODE == 0) { const f32x4 sc = *(const f32x4*)(mod + (size_t)b * 6144 + 4096 + col); scl[bj][n] = scl[bj][n] * (sc + 1.0f); sft[bj][n] = *(const f32x4*)(mod + (size_t)b * 6144 + 3072 + col); } }
#pragma unroll
            for (int ai = 0; ai < 2; ++ai)
#pragma unroll
                for (int m = 0; m < 4; ++m) { const size_t roff = (size_t)(row0 + ai * HALF + m * 16) * 1024 + col0; const float rs = rstd[ai][m];
#pragma unroll
                    for (int bj = 0; bj < 2; ++bj)
#pragma unroll
                        for (int n = 0; n < 2; ++n) { const size_t off = roff + bj * HALF + 4 * n; const f32x4 v = acc[ai][bj][m][n];
                            if (MODE == 0) { *(f32x4*)(xout + off) = v; const f32x4 y = v * rs * scl[bj][n] + sft[bj][n];
                                u32x2 w; w.x = cvt_pk_bf16(y[0], y[1]); w.y = cvt_pk_bf16(y[2], y[3]); *(u32x2*)(h2 + off) = w; }
                            else *(f32x4*)(xout + off) = v * rs * scl[bj][n]; }
                    asm volatile("" ::: "memory"); }
        }
    }
};
template <class Epi, class Sched, bool ALIGN_EPI = false, bool SP2 = false>
__device__ __forceinline__ void gemm_phase(PG8_LAS unsigned char* lds, const Gemm g, const Sched& S, const Epi& E) {
    int tid_ = threadIdx.x; asm volatile("" : "+v"(tid_));
    const int tid = tid_, wid = __builtin_amdgcn_readfirstlane(tid >> 6), lane = tid & 63, wr = wid >> 2, wc = wid & 3, fr = lane & 15, fq = lane >> 4;
    const int K = g.K, nt = K / BK;
    unsigned voffA[2], voffB[2];
#pragma unroll
    for (int i = 0; i < 2; ++i) { int R, C; stage_rc(tid * 16 + i * 8192, R, C); const int Rb = Epi::PERM ? ((R & ~31) + perm32(R & 31)) : R;
        voffA[i] = (unsigned)(R * K + C) * 2u; voffB[i] = (unsigned)(Rb * K + C) * 2u; }
    const size_t kstep = (size_t)(BK * 2);
    const size_t hstep = (size_t)HALF * K * 2;
    const size_t tstep = 2 * hstep;
    const unsigned ldsw = (unsigned)wid * 1024u;
    const int aoff = lds_byte(wr * 64 + fr, fq * 8), boff = lds_byte(wc * 32 + fr, fq * 8);
#define PG8_SA(b, h) (((b) * 2 + (h)) * HTB)
#define PG8_SB(b, h) ((4 + (b) * 2 + (h)) * HTB)
#define PG8_STAGE(bufoff, gbase, voff) do { _Pragma("unroll") for (int _i = 0; _i < 2; ++_i) \
        __builtin_amdgcn_global_load_lds((const unsigned*)((const char*)(gbase) + (voff)[_i]), (PG8_LAS unsigned*)(lds + (bufoff) + ldsw + _i * 8192), 16, 0, 0); } while (0)
#define PG8_LDA(dst, b, h) do { _Pragma("unroll") for (int m = 0; m < 4; ++m) _Pragma("unroll") for (int k = 0; k < 2; ++k) dst[m][k] = *(const PG8_LAS bf16x8*)(lds + PG8_SA(b, h) + aoff + m * 2048 + k * 1024); } while (0)
#define PG8_LDB(dst, b, h) do { _Pragma("unroll") for (int n = 0; n < 2; ++n) _Pragma("unroll") for (int k = 0; k < 2; ++k) dst[n][k] = *(const PG8_LAS bf16x8*)(lds + PG8_SB(b, h) + boff + n * 2048 + k * 1024); } while (0)
#define PG8_MMA(ai, bj, At, Bt) do { __builtin_amdgcn_s_setprio(1); _Pragma("unroll") for (int m = 0; m < 4; ++m) _Pragma("unroll") for (int n = 0; n < 2; ++n) _Pragma("unroll") for (int k = 0; k < 2; ++k) \
        acc[ai][bj][m][n] = __builtin_amdgcn_mfma_f32_16x16x32_bf16(Bt[n][k], At[m][k], acc[ai][bj][m][n], 0, 0, 0); __builtin_amdgcn_s_setprio(0); } while (0)
#define PG8_WAIT_V(n) asm volatile("s_waitcnt vmcnt(" #n ")" ::: "memory")
#define PG8_WAIT_L(n) asm volatile("s_waitcnt lgkmcnt(" #n ")" ::: "memory")
#define PG8_BAR __builtin_amdgcn_s_barrier()
#define PG8_SCHED __builtin_amdgcn_sched_barrier(0)
    Unit cur, nxt; int ui = 0;
    if (!S.next(0, cur)) return;
    f32x4 acc[2][2][4][2];
#pragma unroll
    for (int a = 0; a < 2; ++a)
#pragma unroll
        for (int b = 0; b < 2; ++b)
#pragma unroll
            for (int m = 0; m < 4; ++m)
#pragma unroll
                for (int n = 0; n < 2; ++n) acc[a][b][m][n] = (f32x4){0.f, 0.f, 0.f, 0.f};
    bf16x8 At[4][2], B0[2][2], B1[2][2];
    const char* cA = (const char*)g.A + (size_t)cur.pm * tstep; const char* cB = (const char*)g.Bt + (size_t)cur.pn * tstep;
    S.a_ready(cur);
    if constexpr (SP2) {
        PG8_STAGE(PG8_SB(0, 0), cB, voffB); PG8_STAGE(PG8_SB(0, 1), cB + hstep, voffB); PG8_STAGE(PG8_SA(0, 0), cA, voffA); PG8_STAGE(PG8_SA(0, 1), cA + hstep, voffA);
        if (wr == 1) PG8_BAR;
        PG8_WAIT_V(2); PG8_BAR;
        PG8_STAGE(PG8_SB(1, 0), cB + kstep, voffB); PG8_STAGE(PG8_SA(1, 0), cA + kstep, voffA); PG8_STAGE(PG8_SB(1, 1), cB + hstep + kstep, voffB);
        PG8_WAIT_V(6); PG8_BAR;
    } else {
        PG8_STAGE(PG8_SB(0, 0), cB, voffB); PG8_STAGE(PG8_SA(0, 0), cA, voffA); PG8_STAGE(PG8_SB(0, 1), cB + hstep, voffB); PG8_STAGE(PG8_SA(0, 1), cA + hstep, voffA);
        if (wr == 1) PG8_BAR;
        PG8_WAIT_V(4); PG8_BAR;
        PG8_STAGE(PG8_SB(1, 0), cB + kstep, voffB); PG8_STAGE(PG8_SA(1, 0), cA + kstep, voffA); PG8_STAGE(PG8_SB(1, 1), cB + hstep + kstep, voffB);
        PG8_WAIT_V(6); PG8_BAR;
    }
    for (;;) {
        const bool has_next = S.next(ui + 1, nxt);
        const char* nA = has_next ? (const char*)g.A + (size_t)nxt.pm * tstep : cA; const char* nB = has_next ? (const char*)g.Bt + (size_t)nxt.pn * tstep : cB;
        for (int t = 0; t < nt; t += 2) {
            if constexpr (Epi::MIDK > 0) { if (t == Epi::MIDK) E.mid(acc, cur, wr, wc, fr, fq); }
            const bool last = (t == nt - 2);
            const char* a1 = cA + (size_t)(t + 1) * kstep;
            const char* a2 = last ? nA : cA + (size_t)(t + 2) * kstep; const char* b2 = last ? nB : cB + (size_t)(t + 2) * kstep;
            const char* a3 = a2 + kstep; const char* b3 = b2 + kstep;
            if (last && has_next) S.a_ready(nxt);
            if constexpr (SP2) {
            PG8_LDB(B0, 0, 0); PG8_LDB(B1, 0, 1); PG8_SCHED; PG8_LDA(At, 0, 0); PG8_STAGE(PG8_SA(1, 1), a1 + hstep, voffA);
            PG8_WAIT_V(8); PG8_WAIT_L(0); PG8_BAR; PG8_MMA(0, 0, At, B0); PG8_MMA(0, 1, At, B1); PG8_BAR; PG8_SCHED;
            PG8_LDA(At, 0, 1); PG8_STAGE(PG8_SB(0, 0), b2, voffB); PG8_STAGE(PG8_SB(0, 1), b2 + hstep, voffB); PG8_STAGE(PG8_SA(0, 0), a2, voffA);
            PG8_WAIT_V(8); PG8_WAIT_L(0); PG8_BAR; PG8_MMA(1, 0, At, B0); PG8_MMA(1, 1, At, B1); PG8_BAR; PG8_SCHED;
            PG8_LDB(B0, 1, 0); PG8_LDB(B1, 1, 1); PG8_SCHED; PG8_LDA(At, 1, 0); PG8_STAGE(PG8_SA(0, 1), a2 + hstep, voffA);
            PG8_WAIT_V(8); PG8_WAIT_L(0); PG8_BAR; PG8_MMA(0, 0, At, B0); PG8_MMA(0, 1, At, B1); PG8_BAR; PG8_SCHED;
            PG8_LDA(At, 1, 1); PG8_STAGE(PG8_SB(1, 0), b3, voffB); PG8_STAGE(PG8_SB(1, 1), b3 + hstep, voffB); PG8_STAGE(PG8_SA(1, 0), a3, voffA);
            PG8_WAIT_V(8); PG8_WAIT_L(0); PG8_BAR; PG8_MMA(1, 0, At, B0); PG8_MMA(1, 1, At, B1); PG8_BAR; PG8_SCHED;
            } else {
            PG8_LDB(B0, 0, 0); PG8_SCHED; PG8_LDA(At, 0, 0); PG8_STAGE(PG8_SA(1, 1), a1 + hstep, voffA);
            PG8_WAIT_L(8); PG8_BAR; PG8_WAIT_L(0); PG8_MMA(0, 0, At, B0); PG8_BAR; PG8_SCHED;
            PG8_LDB(B1, 0, 1); PG8_STAGE(PG8_SB(0, 0), b2, voffB);
            PG8_BAR; PG8_WAIT_L(0); PG8_MMA(0, 1, At, B1); PG8_BAR;
            PG8_LDA(At, 0, 1); PG8_STAGE(PG8_SA(0, 0), a2, voffA);
            PG8_BAR; PG8_WAIT_L(0); PG8_MMA(1, 0, At, B0); PG8_BAR; PG8_SCHED;
            PG8_STAGE(PG8_SB(0, 1), b2 + hstep, voffB);
            PG8_WAIT_V(6); PG8_BAR; PG8_MMA(1, 1, At, B1); PG8_BAR;
            PG8_LDB(B0, 1, 0); PG8_SCHED; PG8_LDA(At, 1, 0); PG8_STAGE(PG8_SA(0, 1), a2 + hstep, voffA);
            PG8_WAIT_L(8); PG8_BAR; PG8_WAIT_L(0); PG8_MMA(0, 0, At, B0); PG8_BAR; PG8_SCHED;
            PG8_LDB(B1, 1, 1); PG8_STAGE(PG8_SB(1, 0), b3, voffB);
            PG8_BAR; PG8_WAIT_L(0); PG8_MMA(0, 1, At, B1); PG8_BAR;
            PG8_LDA(At, 1, 1); PG8_STAGE(PG8_SA(1, 0), a3, voffA);
            PG8_BAR; PG8_WAIT_L(0); PG8_MMA(1, 0, At, B0); PG8_BAR; PG8_SCHED;
            PG8_STAGE(PG8_SB(1, 1), b3 + hstep, voffB);
            PG8_WAIT_V(6); PG8_BAR; PG8_MMA(1, 1, At, B1); PG8_BAR;
            }
        }
        if constexpr (ALIGN_EPI) { if (wr == 0) PG8_BAR; }
        if constexpr (!Epi::AFTER_DRAIN) { E(acc, cur, wr, wc, fr, fq); S.done(cur); }
        if (!has_next) break;
#pragma unroll
        for (int a = 0; a < 2; ++a)
#pragma unroll
            for (int b = 0; b < 2; ++b)
#pragma unroll
                for (int m = 0; m < 4; ++m)
#pragma unroll
                    for (int n = 0; n < 2; ++n) acc[a][b][m][n] = (f32x4){0.f, 0.f, 0.f, 0.f};
        cur = nxt; cA = nA; cB = nB; ++ui;
        if constexpr (ALIGN_EPI) { if (wr == 1) PG8_BAR; }
    }
    PG8_WAIT_V(0);
    if constexpr (!ALIGN_EPI) { if (wr == 0) PG8_BAR; }
    PG8_BAR;
    if constexpr (Epi::AFTER_DRAIN) { E.fused(acc, cur, wr, wc, fr, fq, lds, wid, lane); S.done(cur); }
#undef PG8_SA
#undef PG8_SB
#undef PG8_STAGE
#undef PG8_LDA
#undef PG8_LDB
#undef PG8_MMA
#undef PG8_WAIT_V
#undef PG8_WAIT_L
#undef PG8_BAR
#undef PG8_SCHED
}
}

#define LAS __attribute__((address_space(3)))
typedef unsigned short bf16;
typedef float f32x4 __attribute__((ext_vector_type(4)));
typedef short bf16x8 __attribute__((ext_vector_type(8)));
typedef unsigned u32x4 __attribute__((ext_vector_type(4)));
typedef unsigned u32x2 __attribute__((ext_vector_type(2)));

constexpr int DM = 1024, NB = 16, SEQ = 2048, MTOK = NB * SEQ, CTXL = 256, MCTX = NB * CTXL, MALL = MTOK + MCTX;
constexpr int FFH = 2816, NPROJ = 5376;
constexpr float EPS = 1e-6f;
constexpr size_t MiB = 1u << 20;
constexpr size_t WS_WIN = 1 * MiB, WS_WHP = 12 * MiB, WS_WGP = 13 * MiB, WS_WOUT = 14 * MiB, WS_WFI = 16 * MiB, WS_WFO = 27 * MiB;
constexpr size_t WS_MOD = 16384, WS_ROWSS_A = 448 * 1024, WS_ROWSS_B = 576 * 1024, WS_CNT_A = 704 * 1024, WS_CNT_B = 736 * 1024, WS_TMO = 768 * 1024, WS_ZERO_BYTES = 772 * 1024;
constexpr size_t WS_NP = 41 * MiB, WS_KF = 42 * MiB, WS_KB = 46 * MiB;
constexpr size_t WS_XN = 50 * MiB;
constexpr size_t WS_ZT = 50 * MiB, WS_X0T = 82 * MiB, WS_YGLA = 82 * MiB, WS_H2 = 50 * MiB;
constexpr size_t WS_KVA = 122 * MiB;
constexpr size_t WS_MERGED = 122 * MiB;
constexpr size_t WS_HY = 194 * MiB;
constexpr size_t WS_ACAT = 194 * MiB;
constexpr size_t WS_INTF = 50 * MiB, WS_INTB = 82 * MiB, WS_YT = 122 * MiB, WS_YHY = 50 * MiB;
constexpr size_t WS_QR = 290 * MiB;
constexpr size_t WS_GATES = 338 * MiB;
constexpr size_t WS_INTRA = 466 * MiB;
constexpr size_t WS_UP = 122 * MiB, WS_GATE = 298 * MiB;
constexpr size_t WS_NEED = 498 * MiB;
constexpr size_t DO_UPD = 0, DO_QE = 72 * MiB, DO_GG = 104 * MiB;

constexpr int LDS_BYTES = 139264;

struct Params { const float* in[31]; float* out; unsigned char* ws; };

__device__ __forceinline__ float bf2f(unsigned short h) { return __uint_as_float((unsigned)h << 16); }
__device__ __forceinline__ float bflo(unsigned w) { return __uint_as_float(w << 16); }
__device__ __forceinline__ float bfhi(unsigned w) { return __uint_as_float(w & 0xffff0000u); }
__device__ __forceinline__ unsigned f2bf(float f) { unsigned u = __float_as_uint(f); return (u + 0x7fffu + ((u >> 16) & 1u)) >> 16; }
__device__ __forceinline__ unsigned pk2(float lo, float hi) { unsigned r; asm("v_cvt_pk_bf16_f32 %0, %1, %2" : "=v"(r) : "v"(lo), "v"(hi)); return r; }
__device__ __forceinline__ float wave_sum(float v) {
#pragma unroll
    for (int o = 1; o < 64; o <<= 1) v += __shfl_xor(v, o);
    return v;
}
__device__ __forceinline__ float silu_f(float x) { return x / (1.0f + __expf(-x)); }

__device__ __forceinline__ void transpose_item(const float* W, int K, int N, int src_n0, bf16* WT, int dst_n0, int k0, float* scr, int lane, int kofs = 0) {
    if (src_n0 >= 0) {
        float tv_[32];
#pragma unroll
        for (int i = 0; i < 32; ++i) { const int kk = 2 * i + (lane >> 5); tv_[i] = W[(size_t)(k0 + kk) * N + src_n0 + (lane & 31)]; }
#pragma unroll
        for (int i = 0; i < 32; ++i) { const int kk = 2 * i + (lane >> 5); scr[kk * 33 + (lane & 31)] = tv_[i]; }
    }
    __builtin_amdgcn_wave_barrier();
    const int c = lane & 7;
#pragma unroll
    for (int j = 0; j < 4; ++j) { const int n = (lane >> 3) + 8 * j; const float* s = scr + (8 * c) * 33 + n;
        u32x4 o;
        if (src_n0 >= 0) { o.x = pk2(s[0 * 33], s[1 * 33]); o.y = pk2(s[2 * 33], s[3 * 33]); o.z = pk2(s[4 * 33], s[5 * 33]); o.w = pk2(s[6 * 33], s[7 * 33]); }
        else { o.x = 0; o.y = 0; o.z = 0; o.w = 0; }
        *(u32x4*)(WT + (size_t)(dst_n0 + n) * K + kofs + k0 + 8 * c) = o; }
    __builtin_amdgcn_wave_barrier();
}
__device__ __forceinline__ int win_src(int n0) {
    if (n0 < 256) return 1792 + n0;
    if (n0 < 768) return 2048 + (n0 - 256);
    if (n0 < 800) return 3072 + (n0 - 768);
    if (n0 < 1024) return -1;
    if (n0 < 2560) return n0 - 1024;
    if (n0 < 2816) return 1536 + (n0 - 2560);
    if (n0 < 3328) return 2560 + (n0 - 2816);
    return 3104 + (n0 - 3328);
}

__device__ __forceinline__ void phase0(const Params& P, unsigned char* lds, int G, int bid, int tid, const bool do_ada = true) {
    const int lane = tid & 63, wave = tid >> 6;
    unsigned char* ws = P.ws;
    if (do_ada) {
        float* sl = (float*)lds;
        for (int e = tid; e < 17 * 1024; e += 512) { const int bi = e >> 10, k = e & 1023; const float v = bi < 16 ? P.in[1][bi * 1024 + k] : P.in[3][k]; sl[e] = silu_f(v); }
        __syncthreads();
        const float* wada = P.in[4]; const float* bada = P.in[5]; float* MOD = (float*)(ws + WS_MOD);
        for (int gid = bid * 512 + tid; gid < 6144 * 16; gid += G * 512) {
            const int n = gid % 6144, ks = gid / 6144, k0 = ks * 64;
            float acc[17];
            const float bz = ks == 0 ? bada[n] : 0.f;
#pragma unroll
            for (int bi = 0; bi < 17; ++bi) acc[bi] = bz;
            float w[64];
#pragma unroll
            for (int j = 0; j < 64; ++j) w[j] = wada[(size_t)(k0 + j) * 6144 + n];
#pragma unroll
            for (int kb = 0; kb < 8; ++kb) {
#pragma unroll
                for (int bi = 0; bi < 17; ++bi) { const f32x4 s0 = *(const f32x4*)(sl + bi * 1024 + k0 + 8 * kb), s1 = *(const f32x4*)(sl + bi * 1024 + k0 + 8 * kb + 4);
                    acc[bi] += (s0.x * w[8 * kb] + s0.y * w[8 * kb + 1]) + (s0.z * w[8 * kb + 2] + s0.w * w[8 * kb + 3]) + (s1.x * w[8 * kb + 4] + s1.y * w[8 * kb + 5]) + (s1.z * w[8 * kb + 6] + s1.w * w[8 * kb + 7]); }
                asm volatile("" ::: "memory");
            }
#pragma unroll
            for (int bi = 0; bi < 17; ++bi) atomicAdd(MOD + bi * 6144 + n, acc[bi]);
        }
        __syncthreads();
    }
    {
        float* feats = (float*)lds;
        float* h1 = feats + 8 * 36;
        float* h2 = h1 + 8 * 64;
        const float *w1 = P.in[10], *b1 = P.in[11], *w2 = P.in[12], *b2 = P.in[13], *w3 = P.in[14], *freq = P.in[15], *decay = P.in[16];
        float* KF = (float*)(ws + WS_KF); float* KBk = (float*)(ws + WS_KB); float* NP = (float*)(ws + WS_NP);
        for (int rt = bid; rt < 256; rt += G) {
            const int i0 = rt * 8;
            if (tid < 8 * 33) { const int r = tid / 33, j = tid % 33; const int i = i0 + r;
                const float t = (float)i / 2047.0f, w = 0.0030679615757712823f * (float)i;
                float v;
                if (j == 0) v = t;
                else if (j <= 16) { const float f = 1e-4f + (float)(j - 1) * ((15.0f - 1e-4f) / 15.0f); v = cosf(f * w); }
                else { const float f = 1e-4f + (float)(j - 17) * ((15.0f - 1e-4f) / 15.0f); v = -sinf(f * w); }
                feats[r * 36 + j] = v; }
            __syncthreads();
            { const int r = tid >> 6, m = tid & 63; float s = b1[m]; float wv_[33];
#pragma unroll
              for (int j = 0; j < 33; ++j) wv_[j] = w1[j * 64 + m];
#pragma unroll
              for (int j = 0; j < 33; ++j) s += feats[r * 36 + j] * wv_[j];
              h1[r * 64 + m] = sinf(freq[m] * s); }
            __syncthreads();
            { const int r = tid >> 6, m = tid & 63; float s = b2[m];
#pragma unroll
              for (int j0 = 0; j0 < 64; j0 += 16) { float wv_[16];
#pragma unroll
                  for (int j = 0; j < 16; ++j) wv_[j] = w2[(j0 + j) * 64 + m];
#pragma unroll
                  for (int j = 0; j < 16; ++j) s += h1[r * 64 + j0 + j] * wv_[j]; }
              h2[r * 64 + m] = sinf(freq[m] * s); }
            __syncthreads();
#pragma unroll
            for (int half = 0; half < 2; ++half) {
                const int n = tid + 512 * half;
                float acc[8];
#pragma unroll
                for (int r = 0; r < 8; ++r) acc[r] = 0.f;
#pragma unroll 1
                for (int m0 = 0; m0 < 64; m0 += 8) { float wv_[8];
#pragma unroll
                    for (int j = 0; j < 8; ++j) wv_[j] = w3[(m0 + j) * 1024 + n];
#pragma unroll
                    for (int r = 0; r < 8; ++r) { const f32x4 a = *(const f32x4*)(h2 + r * 64 + m0), b = *(const f32x4*)(h2 + r * 64 + m0 + 4);
                        acc[r] += (a.x * wv_[0] + a.y * wv_[1]) + (a.z * wv_[2] + a.w * wv_[3]) + (b.x * wv_[4] + b.y * wv_[5]) + (b.z * wv_[6] + b.w * wv_[7]); } }
                const float dc = decay[n]; float asum = 0.f;
#pragma unroll
                for (int r = 0; r < 8; ++r) { const int i = i0 + r; const float t = (float)i / 2047.0f; acc[r] *= expf(-t * dc);
                    if (!(half == 1 && i == 0)) asum += fabsf(acc[r]); }
                float* dst = (half == 0 ? KF + (size_t)n * 2048 : KBk + (size_t)(n - 512) * 2048) + i0;
                *(f32x4*)dst = (f32x4){acc[0], acc[1], acc[2], acc[3]}; *(f32x4*)(dst + 4) = (f32x4){acc[4], acc[5], acc[6], acc[7]};
                NP[rt * 1024 + n] = asum;
            }
            __syncthreads();
        }
    }
    {
        float* scr = (float*)(lds + wave * 8704);
        const int gw = bid * 8 + wave, NGW = G * 8;
        constexpr int I_IN = 16 * 168, I_HP = 8 * 32, I_GP = 8 * 32, I_OUT = 16 * 32, I_FI = 16 * 176, I_FO = 44 * 32;
        constexpr int NIT = I_IN + I_HP + I_GP + I_OUT + I_FI + I_FO;
        for (int it = gw; it < NIT; it += NGW) {
            int r = it;
            if (r < I_IN) { const int kb = r / 168, nb = r % 168; transpose_item(P.in[8], 1024, 5152, win_src(32 * nb), (bf16*)(ws + WS_WIN), 32 * nb, 64 * kb, scr, lane); continue; } r -= I_IN;
            if (r < I_HP) { const int kb = r / 32, nb = r % 32; transpose_item(P.in[23], 1024, 1024, 32 * nb, (bf16*)(ws + WS_WHP), 32 * nb, 64 * kb, scr, lane, 0); continue; } r -= I_HP;
            if (r < I_GP) { const int kb = r / 32, nb = r % 32; transpose_item(P.in[24], 1024, 1024, 32 * nb, (bf16*)(ws + WS_WHP), 32 * nb, 64 * kb, scr, lane, 512); continue; } r -= I_GP;
            if (r < I_OUT) { const int kb = r / 32, nb = r % 32; transpose_item(P.in[25], 1024, 1024, 32 * nb, (bf16*)(ws + WS_WOUT), 32 * nb, 64 * kb, scr, lane); continue; } r -= I_OUT;
            if (r < I_FI) { const int kb = r / 176, nb = r % 176; transpose_item(P.in[26], 1024, 5632, 32 * nb, (bf16*)(ws + WS_WFI), 32 * nb, 64 * kb, scr, lane); continue; } r -= I_FI;
            { const int kb = r / 32, nb = r % 32; transpose_item(P.in[29], 2816, 1024, 32 * nb, (bf16*)(ws + WS_WFO), 32 * nb, 64 * kb, scr, lane); }
        }
    }
}

__device__ __forceinline__ void norm_rows2_bf16(const float* xa, const float* xb, bf16* oa, bf16* ob, bool hasb, const float* scl, const float* sft, int lane) {
    const f32x4* xra = (const f32x4*)xa + lane; const f32x4* xrb = (const f32x4*)(hasb ? xb : xa) + lane;
    f32x4 va[4], vb[4]; float sa = 0.f, sb = 0.f;
#pragma unroll
    for (int j = 0; j < 4; ++j) { va[j] = xra[64 * j]; vb[j] = xrb[64 * j]; }
#pragma unroll
    for (int j = 0; j < 4; ++j) { sa += (va[j].x * va[j].x + va[j].y * va[j].y) + (va[j].z * va[j].z + va[j].w * va[j].w);
        sb += (vb[j].x * vb[j].x + vb[j].y * vb[j].y) + (vb[j].z * vb[j].z + vb[j].w * vb[j].w); }
    const float ra = rsqrtf(wave_sum(sa) * (1.f / 1024.f) + EPS), rb = rsqrtf(wave_sum(sb) * (1.f / 1024.f) + EPS);
    unsigned long long* o8a = (unsigned long long*)oa + lane; unsigned long long* o8b = (unsigned long long*)ob + lane;
#pragma unroll
    for (int j = 0; j < 4; ++j) { const f32x4 sc = *((const f32x4*)scl + lane + 64 * j), sf = *((const f32x4*)sft + lane + 64 * j);
        const f32x4 ya = va[j] * ra * sc + sf, yb = vb[j] * rb * sc + sf;
        o8a[64 * j] = (unsigned long long)pk2(ya.x, ya.y) | ((unsigned long long)pk2(ya.z, ya.w) << 32);
        if (hasb) o8b[64 * j] = (unsigned long long)pk2(yb.x, yb.y) | ((unsigned long long)pk2(yb.z, yb.w) << 32); }
}

__device__ __forceinline__ void phase1(const Params& P, unsigned char* lds, int G, int bid, int tid) {
    const int lane = tid & 63, wave = tid >> 6;
    unsigned char* ws = P.ws;
    const float* MOD = (const float*)(ws + WS_MOD);
    float* scl = (float*)lds; float* sft = scl + 1024;
    const int per = (MALL + G - 1) / G; const int r0 = bid * per, r1 = min(MALL, r0 + per);
    int rs = r0;
    while (rs < r1) {
        const int bi = rs < MTOK ? rs / SEQ : 16;
        const int segend = rs < MTOK ? min(r1, (bi + 1) * SEQ) : r1;
        for (int k = tid; k < 1024; k += 512) { scl[k] = P.in[6][k] * (1.0f + MOD[bi * 6144 + 1024 + k]); sft[k] = MOD[bi * 6144 + k]; }
        __syncthreads();
        for (int row = rs + wave; row < segend; row += 16) {
            const int rowb = row + 8; const bool hasb = rowb < segend;
            const float* sa = row < MTOK ? P.in[0] + (size_t)row * 1024 : P.in[2] + (size_t)(row - MTOK) * 1024;
            const float* sb = rowb < MTOK ? P.in[0] + (size_t)rowb * 1024 : P.in[2] + (size_t)(rowb - MTOK) * 1024;
            norm_rows2_bf16(sa, sb, (bf16*)(ws + WS_XN) + (size_t)row * 1024, (bf16*)(ws + WS_XN) + (size_t)rowb * 1024, hasb, scl, sft, lane);
        }
        __syncthreads();
        rs = segend;
    }
}

__device__ __forceinline__ void phase6(const Params& P, unsigned char* lds, int G, int bid, int tid) {
    const int lane = tid & 63, wave = tid >> 6;
    unsigned char* ws = P.ws; const float* MOD = (const float*)(ws + WS_MOD);
    float* scl = (float*)lds; float* sft = scl + 1024;
    const int per = (MTOK + G - 1) / G; const int r0 = bid * per, r1 = min(MTOK, r0 + per);
    int rs = r0;
    while (rs < r1) {
        const int bi = rs / SEQ; const int segend = min(r1, (bi + 1) * SEQ);
        for (int k = tid; k < 1024; k += 512) { scl[k] = P.in[7][k] * (1.0f + MOD[bi * 6144 + 4096 + k]); sft[k] = MOD[bi * 6144 + 3072 + k]; }
        __syncthreads();
        for (int row = rs + wave; row < segend; row += 16) { const int rowb = row + 8;
            norm_rows2_bf16(P.out + (size_t)row * 1024, P.out + (size_t)rowb * 1024, (bf16*)(ws + WS_H2) + (size_t)row * 1024, (bf16*)(ws + WS_H2) + (size_t)rowb * 1024, rowb < segend, scl, sft, lane); }
        __syncthreads();
        rs = segend;
    }
}

__device__ __forceinline__ void phase10(const Params& P, int G, int bid, int tid) {
    const int lane = tid & 63, wave = tid >> 6; const int gw = bid * 8 + wave, NGW = G * 8;
    const float* fw = P.in[30];
    f32x4 wv[4];
#pragma unroll
    for (int j = 0; j < 4; ++j) wv[j] = *((const f32x4*)fw + lane + 64 * j);
    for (int row = gw; row < MTOK; row += 2 * NGW) {
        const int rowb = row + NGW; const bool hasb = rowb < MTOK;
        f32x4* xa = (f32x4*)(P.out + (size_t)row * 1024) + lane; f32x4* xb = (f32x4*)(P.out + (size_t)(hasb ? rowb : row) * 1024) + lane;
        f32x4 va[4], vb[4]; float sa = 0.f, sb = 0.f;
#pragma unroll
        for (int j = 0; j < 4; ++j) { va[j] = xa[64 * j]; vb[j] = xb[64 * j]; }
#pragma unroll
        for (int j = 0; j < 4; ++j) { sa += (va[j].x * va[j].x + va[j].y * va[j].y) + (va[j].z * va[j].z + va[j].w * va[j].w);
            sb += (vb[j].x * vb[j].x + vb[j].y * vb[j].y) + (vb[j].z * vb[j].z + vb[j].w * vb[j].w); }
        const float ra = rsqrtf(wave_sum(sa) * (1.f / 1024.f) + EPS), rb = rsqrtf(wave_sum(sb) * (1.f / 1024.f) + EPS);
#pragma unroll
        for (int j = 0; j < 4; ++j) { xa[64 * j] = va[j] * ra * wv[j]; if (hasb) xb[64 * j] = vb[j] * rb * wv[j]; }
    }
}

__device__ __forceinline__ void hyena_pre(const Params& P, unsigned char* lds, int G, int bid, int tid) {
    unsigned char* ws = P.ws;
    const bf16* HY = (const bf16*)(ws + WS_HY); bf16* ZT = (bf16*)(ws + WS_ZT); bf16* X0T = (bf16*)(ws + WS_X0T);
    bf16* ZL = (bf16*)lds; bf16* XL = ZL + 512 * 66;
    const float* cw = P.in[9];
    const int c = tid;
    float w0[3], w1[3], wv[3];
#pragma unroll
    for (int j = 0; j < 3; ++j) { w0[j] = cw[j * 1536 + c]; w1[j] = cw[j * 1536 + 512 + c]; wv[j] = cw[j * 1536 + 1024 + c]; }
    for (int u = bid; u < 512; u += G) {
        const int b = u >> 5, t0 = (u & 31) * 64;
        const bf16* base = HY + (size_t)b * SEQ * 1536;
        float p0, p1, pv, c0, c1, cv;
        if (t0 > 0) { const bf16* r = base + (size_t)(t0 - 1) * 1536; p0 = bf2f(r[c]); p1 = bf2f(r[512 + c]); pv = bf2f(r[1024 + c]); } else { p0 = p1 = pv = 0.f; }
        { const bf16* r = base + (size_t)t0 * 1536; c0 = bf2f(r[c]); c1 = bf2f(r[512 + c]); cv = bf2f(r[1024 + c]); }
        for (int i0 = 0; i0 < 64; i0 += 8) {
            unsigned short r0[8], r1[8], rv[8];
#pragma unroll
            for (int k = 0; k < 8; ++k) { const int tn = t0 + i0 + k + 1;
                if (tn < SEQ) { const bf16* r = base + (size_t)tn * 1536; r0[k] = r[c]; r1[k] = r[512 + c]; rv[k] = r[1024 + c]; } else { r0[k] = 0; r1[k] = 0; rv[k] = 0; } }
#pragma unroll
            for (int k = 0; k < 8; ++k) {
                const float n0 = bf2f(r0[k]), n1 = bf2f(r1[k]), nv = bf2f(rv[k]);
                const float x0 = w0[0] * p0 + w0[1] * c0 + w0[2] * n0;
                const float x1 = w1[0] * p1 + w1[1] * c1 + w1[2] * n1;
                const float vv = wv[0] * pv + wv[1] * cv + wv[2] * nv;
                ZL[c * 66 + i0 + k] = (bf16)f2bf(x1 * vv); XL[c * 66 + i0 + k] = (bf16)f2bf(x0);
                p0 = c0; p1 = c1; pv = cv; c0 = n0; c1 = n1; cv = nv;
            }
        }
        __syncthreads();
        const unsigned* ZLw = (const unsigned*)ZL; const unsigned* XLw = (const unsigned*)XL;
        for (int it = 0; it < 32; ++it) { const int e = it * 512 + tid, row = e >> 5, w = e & 31;
            const size_t go = ((size_t)(row * 16 + b) * SEQ + t0) / 2 + w;
            ((unsigned*)ZT)[go] = ZLw[row * 33 + w]; ((unsigned*)X0T)[go] = XLw[row * 33 + w]; }
        __syncthreads();
    }
}

__device__ __forceinline__ bf16x8 ldfrag(const bf16* base, int row, int kk, int q) { return *(const bf16x8*)(base + row * 72 + 32 * kk + 8 * q); }

__device__ __forceinline__ void gla_pre(const Params& P, unsigned char* lds, int G, int bid, int tid) {
    unsigned char* ws = P.ws;
    const int lane = tid & 63, wave = tid >> 6, fr = lane & 15, fq = lane >> 4;
    const bf16* KVA = (const bf16*)(ws + WS_KVA); const bf16* QR = (const bf16*)(ws + WS_QR);
    bf16* INTRA = (bf16*)(ws + WS_INTRA);
    bf16* UPD = (bf16*)((unsigned char*)P.out + DO_UPD); bf16* QEG = (bf16*)((unsigned char*)P.out + DO_QE); float* GG = (float*)((unsigned char*)P.out + DO_GG);
    float* bF = (float*)lds; float* bB = bF + 4096;
    bf16* QEF = (bf16*)(lds + 32768); bf16* KEF = QEF + 4608; bf16* QEB = KEF + 4608; bf16* KEB = QEB + 4608;
    bf16* KDTF = KEB + 4608; bf16* KDTB = KDTF + 4608; bf16* VT = KDTB + 4608; bf16* PP = VT + 9216;
    float* tot = (float*)(PP + 4608);
    bf16* AL = (bf16*)(tot + 512);
    u32x4 pa = {0u, 0u, 0u, 0u}, pk = pa, pq = pa, pva = pa, pvb = pa;
#define GLA_PREFETCH(uu) do { const int b_ = (uu) / 144, h_ = ((uu) / 36) & 3, ch_ = (uu) % 36; const bool lat_ = ch_ < 32; \
        const int rb_ = lat_ ? b_ * SEQ + 64 * ch_ : MTOK + b_ * CTXL + 64 * (ch_ - 32); \
        if (tid < 256) pa = *(const u32x4*)(KVA + (size_t)(rb_ + (tid >> 2)) * 1024 + 768 + 8 * (tid & 3)); \
        const size_t row_ = (size_t)(rb_ + (tid >> 3)); const int d0_ = 8 * (tid & 7), v0_ = 16 * (tid & 7); \
        pk = *(const u32x4*)(KVA + row_ * 1024 + h_ * 64 + d0_); \
        if (lat_) pq = *(const u32x4*)(QR + row_ * 768 + h_ * 64 + d0_); \
        pva = *(const u32x4*)(KVA + row_ * 1024 + 256 + h_ * 128 + v0_); pvb = *(const u32x4*)(KVA + row_ * 1024 + 256 + h_ * 128 + v0_ + 8); } while (0)
    if (bid < 16 * 4 * 36) GLA_PREFETCH(bid);
    for (int u = bid; u < 16 * 4 * 36; u += G) {
        const int b = u / 144, h = (u / 36) & 3, ch = u % 36;
        const bool lat = ch < 32;
        const int rowbase = lat ? b * SEQ + 64 * ch : MTOK + b * CTXL + 64 * (ch - 32);
        if (tid < 256) *(u32x4*)(AL + (tid >> 2) * 32 + 8 * (tid & 3)) = pa;
        __syncthreads();
        {
            const int dir = __builtin_amdgcn_readfirstlane(tid >> 8), tg = __builtin_amdgcn_readfirstlane((tid >> 6) & 3), d = tid & 63;
            const float* upw = dir == 0 ? P.in[18] : P.in[20]; const float* ab = dir == 0 ? P.in[19] : P.in[21];
            float up[16];
#pragma unroll
            for (int j = 0; j < 16; ++j) up[j] = upw[j * 256 + h * 64 + d];
            const float bias = ab[h * 64 + d];
            float pre[16]; float run = 0.f;
#pragma unroll
            for (int i = 0; i < 16; ++i) {
                const bf16* ap = AL + (16 * tg + i) * 32 + 16 * dir;
                const u32x4 a0 = *(const u32x4*)ap, a1 = *(const u32x4*)(ap + 8);
                float x = bias;
                x += bflo(a0.x) * up[0] + bfhi(a0.x) * up[1] + bflo(a0.y) * up[2] + bfhi(a0.y) * up[3] + bflo(a0.z) * up[4] + bfhi(a0.z) * up[5] + bflo(a0.w) * up[6] + bfhi(a0.w) * up[7];
                x += bflo(a1.x) * up[8] + bfhi(a1.x) * up[9] + bflo(a1.y) * up[10] + bfhi(a1.y) * up[11] + bflo(a1.z) * up[12] + bfhi(a1.z) * up[13] + bflo(a1.w) * up[14] + bfhi(a1.w) * up[15];
                const float ls = fminf(x, 0.f) - __logf(1.0f + __expf(-fabsf(x)));
                run += ls * (1.0f / 16.0f); pre[i] = run;
            }
            tot[(dir * 4 + tg) * 64 + d] = run;
            __syncthreads();
            float off = 0.f;
            if (dir == 0) { for (int g = 0; g < 4; ++g) if (g < tg) off += tot[g * 64 + d]; }
            else { for (int g = 0; g < 4; ++g) if (g > tg) off += tot[(4 + g) * 64 + d]; }
            if (dir == 0) {
#pragma unroll
                for (int i = 0; i < 16; ++i) bF[(16 * tg + i) * 64 + d] = off + pre[i];
            } else {
#pragma unroll
                for (int i = 0; i < 16; ++i) { const float excl = i == 0 ? 0.f : pre[i - 1]; bB[(16 * tg + i) * 64 + d] = off + (run - excl); }
            }
        }
        __syncthreads();
        {
            const int t = tid >> 3, d0 = 8 * (tid & 7); const size_t row = (size_t)(rowbase + t);
            const u32x4 k8 = pk;
            float kf[8] = {bflo(k8.x), bfhi(k8.x), bflo(k8.y), bfhi(k8.y), bflo(k8.z), bfhi(k8.z), bflo(k8.w), bfhi(k8.w)};
            float qf[8];
            if (lat) { const u32x4 q8 = pq;
                qf[0] = bflo(q8.x); qf[1] = bfhi(q8.x); qf[2] = bflo(q8.y); qf[3] = bfhi(q8.y); qf[4] = bflo(q8.z); qf[5] = bfhi(q8.z); qf[6] = bflo(q8.w); qf[7] = bfhi(q8.w); }
            else {
#pragma unroll
                for (int j = 0; j < 8; ++j) qf[j] = 0.f; }
            float qef[8], kef[8], qeb[8], keb[8];
#pragma unroll
            for (int j = 0; j < 8; ++j) {
                const float f = bF[t * 64 + d0 + j], fl = bF[63 * 64 + d0 + j], bb = bB[t * 64 + d0 + j], b0 = bB[d0 + j];
                const float ef = __expf(f), eb = __expf(bb);
                qef[j] = qf[j] * 0.125f * ef; kef[j] = kf[j] * __expf(-f); qeb[j] = qf[j] * 0.125f * eb; keb[j] = kf[j] * __expf(-bb);
                KDTF[(d0 + j) * 72 + t] = (bf16)f2bf(kf[j] * __expf(fl - f));
                KDTB[(d0 + j) * 72 + t] = (bf16)f2bf(kf[j] * __expf(b0 - bb));
            }
            if (lat) {
                u32x4 w;
                w.x = pk2(qef[0], qef[1]); w.y = pk2(qef[2], qef[3]); w.z = pk2(qef[4], qef[5]); w.w = pk2(qef[6], qef[7]);
                *(u32x4*)(QEF + t * 72 + d0) = w; *(u32x4*)(QEG + ((size_t)((b * 4 + h) * 2 + 0) * 32 + ch) * 4096 + t * 64 + d0) = w;
                w.x = pk2(qeb[0], qeb[1]); w.y = pk2(qeb[2], qeb[3]); w.z = pk2(qeb[4], qeb[5]); w.w = pk2(qeb[6], qeb[7]);
                *(u32x4*)(QEB + t * 72 + d0) = w; *(u32x4*)(QEG + ((size_t)((b * 4 + h) * 2 + 1) * 32 + ch) * 4096 + t * 64 + d0) = w;
                w.x = pk2(kef[0], kef[1]); w.y = pk2(kef[2], kef[3]); w.z = pk2(kef[4], kef[5]); w.w = pk2(kef[6], kef[7]);
                *(u32x4*)(KEF + t * 72 + d0) = w;
                w.x = pk2(keb[0], keb[1]); w.y = pk2(keb[2], keb[3]); w.z = pk2(keb[4], keb[5]); w.w = pk2(keb[6], keb[7]);
                *(u32x4*)(KEB + t * 72 + d0) = w;
            }
            const int v0 = 16 * (tid & 7);
            const u32x4 va = pva, vb = pvb;
            const unsigned vw[8] = {va.x, va.y, va.z, va.w, vb.x, vb.y, vb.z, vb.w};
#pragma unroll
            for (int j = 0; j < 8; ++j) { VT[(v0 + 2 * j) * 72 + t] = (bf16)(vw[j] & 0xffffu); VT[(v0 + 2 * j + 1) * 72 + t] = (bf16)(vw[j] >> 16); }
            if (tid < 128) { const int dir = tid >> 6, d = tid & 63;
                GG[((size_t)((b * 4 + h) * 2 + dir) * 36 + ch) * 64 + d] = dir == 0 ? __expf(bF[63 * 64 + d]) : __expf(bB[d]); }
        }
        __syncthreads();
        if (u + G < 16 * 4 * 36) GLA_PREFETCH(u + G);
        {
            if (lat) {
                const int m = wave >> 1;
#pragma unroll
                for (int nn = 0; nn < 2; ++nn) { const int n = 2 * (wave & 1) + nn;
                    f32x4 af = {0.f, 0.f, 0.f, 0.f}, ab = {0.f, 0.f, 0.f, 0.f};
#pragma unroll
                    for (int kk = 0; kk < 2; ++kk) {
                        af = __builtin_amdgcn_mfma_f32_16x16x32_bf16(ldfrag(QEF, 16 * m + fr, kk, fq), ldfrag(KEF, 16 * n + fr, kk, fq), af, 0, 0, 0);
                        ab = __builtin_amdgcn_mfma_f32_16x16x32_bf16(ldfrag(QEB, 16 * m + fr, kk, fq), ldfrag(KEB, 16 * n + fr, kk, fq), ab, 0, 0, 0); }
                    const int s = 16 * n + fr;
#pragma unroll
                    for (int i = 0; i < 4; ++i) { const int cidx = 16 * m + 4 * fq + i;
                        const float v = (s <= cidx ? af[i] : 0.f) + (s >= cidx ? ab[i] : 0.f);
                        PP[cidx * 72 + s] = (bf16)f2bf(v); }
                }
            }
#pragma unroll
            for (int dir = 0; dir < 2; ++dir) { const bf16* KDT = dir == 0 ? KDTF : KDTB;
                bf16* up = UPD + ((size_t)((b * 4 + h) * 2 + dir) * 36 + ch) * 8192;
                const bf16x8 a0 = ldfrag(VT, 16 * wave + fr, 0, fq), a1 = ldfrag(VT, 16 * wave + fr, 1, fq);
#pragma unroll
                for (int nd = 0; nd < 4; ++nd) {
                    f32x4 acc = {0.f, 0.f, 0.f, 0.f};
                    acc = __builtin_amdgcn_mfma_f32_16x16x32_bf16(a0, ldfrag(KDT, 16 * nd + fr, 0, fq), acc, 0, 0, 0);
                    acc = __builtin_amdgcn_mfma_f32_16x16x32_bf16(a1, ldfrag(KDT, 16 * nd + fr, 1, fq), acc, 0, 0, 0);
#pragma unroll
                    for (int i = 0; i < 4; ++i) up[(16 * wave + 4 * fq + i) * 64 + 16 * nd + fr] = (bf16)f2bf(acc[i]);
                }
            }
        }
        __syncthreads();
        if (lat) {
            const bf16x8 b0 = ldfrag(VT, 16 * wave + fr, 0, fq), b1 = ldfrag(VT, 16 * wave + fr, 1, fq);
#pragma unroll
            for (int m = 0; m < 4; ++m) {
                f32x4 acc = {0.f, 0.f, 0.f, 0.f};
                acc = __builtin_amdgcn_mfma_f32_16x16x32_bf16(ldfrag(PP, 16 * m + fr, 0, fq), b0, acc, 0, 0, 0);
                acc = __builtin_amdgcn_mfma_f32_16x16x32_bf16(ldfrag(PP, 16 * m + fr, 1, fq), b1, acc, 0, 0, 0);
#pragma unroll
                for (int i = 0; i < 4; ++i) INTRA[(size_t)(rowbase + 16 * m + 4 * fq + i) * 512 + h * 128 + 16 * wave + fr] = (bf16)f2bf(acc[i]);
            }
        }
    }
    __syncthreads();
}

struct ScanLd { u32x4 uw[2]; f32x4 gv[2][2]; bf16x8 a[2][2]; };
__device__ __forceinline__ int scan_chunk(int dir, int step) { return dir == 0 ? (step < 4 ? 32 + step : step - 4) : 35 - step; }
__device__ __forceinline__ void scan_load(ScanLd& L, const bf16* UPD, const bf16* QEG, const float* GG, int bh, int dir, int ch, int dvs, int mh, int n, int q) {
    const size_t ud = (size_t)(bh * 2 + dir) * 36 + ch;
#pragma unroll
    for (int kk = 0; kk < 2; ++kk) { L.uw[kk] = *(const u32x4*)(UPD + (ud * 128 + 16 * dvs + n) * 64 + 32 * kk + 8 * q);
        L.gv[kk][0] = *(const f32x4*)(GG + ud * 64 + 32 * kk + 8 * q); L.gv[kk][1] = *(const f32x4*)(GG + ud * 64 + 32 * kk + 8 * q + 4); }
    if (ch < 32) { const bf16* qe = QEG + ((size_t)(bh * 2 + dir) * 32 + ch) * 4096;
#pragma unroll
        for (int mm = 0; mm < 2; ++mm)
#pragma unroll
            for (int kk = 0; kk < 2; ++kk) L.a[mm][kk] = *(const bf16x8*)(qe + (16 * (2 * mh + mm) + n) * 64 + 32 * kk + 8 * q); }
}
__device__ __forceinline__ void gla_scan(const Params& P, int G, int bid, int tid) {
    unsigned char* ws = P.ws;
    const int lane = tid & 63, wave = tid >> 6, n = lane & 15, q = lane >> 4;
    const bf16* UPD = (const bf16*)((unsigned char*)P.out + DO_UPD); const bf16* QEG = (const bf16*)((unsigned char*)P.out + DO_QE); const float* GG = (const float*)((unsigned char*)P.out + DO_GG);
    for (int wu = bid * 8 + wave; wu < 2048; wu += G * 8) {
        const int mh = wu & 1, dvs = (wu >> 1) & 7, dir = (wu >> 4) & 1, bh = wu >> 5, b = bh >> 2, h = bh & 3;
        bf16* INTER = (bf16*)(ws + (dir == 0 ? WS_INTF : WS_INTB));
        float S[2][8];
#pragma unroll
        for (int kk = 0; kk < 2; ++kk)
#pragma unroll
            for (int j = 0; j < 8; ++j) S[kk][j] = 0.f;
        ScanLd L0, L1;
        scan_load(L0, UPD, QEG, GG, bh, dir, scan_chunk(dir, 0), dvs, mh, n, q);
        scan_load(L1, UPD, QEG, GG, bh, dir, scan_chunk(dir, 1), dvs, mh, n, q);
#define SCAN_STEP(LL, st) do { const int ch = scan_chunk(dir, (st)); \
            if (ch < 32) { bf16x8 Bf[2]; \
                _Pragma("unroll") for (int kk = 0; kk < 2; ++kk) { u32x4 w; w.x = pk2(S[kk][0], S[kk][1]); w.y = pk2(S[kk][2], S[kk][3]); w.z = pk2(S[kk][4], S[kk][5]); w.w = pk2(S[kk][6], S[kk][7]); Bf[kk] = __builtin_bit_cast(bf16x8, w); } \
                _Pragma("unroll") for (int mm = 0; mm < 2; ++mm) { const int mt = 2 * mh + mm; f32x4 acc = {0.f, 0.f, 0.f, 0.f}; \
                    _Pragma("unroll") for (int kk = 0; kk < 2; ++kk) acc = __builtin_amdgcn_mfma_f32_16x16x32_bf16(LL.a[mm][kk], Bf[kk], acc, 0, 0, 0); \
                    _Pragma("unroll") for (int i = 0; i < 4; ++i) INTER[(size_t)(b * SEQ + 64 * ch + 16 * mt + 4 * q + i) * 512 + h * 128 + 16 * dvs + n] = (bf16)f2bf(acc[i]); } } \
            _Pragma("unroll") for (int kk = 0; kk < 2; ++kk) { \
                const float uf[8] = {bflo(LL.uw[kk].x), bfhi(LL.uw[kk].x), bflo(LL.uw[kk].y), bfhi(LL.uw[kk].y), bflo(LL.uw[kk].z), bfhi(LL.uw[kk].z), bflo(LL.uw[kk].w), bfhi(LL.uw[kk].w)}; \
                _Pragma("unroll") for (int j = 0; j < 8; ++j) S[kk][j] = LL.gv[kk][j >> 2][j & 3] * S[kk][j] + uf[j]; } \
            if ((st) + 2 < 36) scan_load(LL, UPD, QEG, GG, bh, dir, scan_chunk(dir, (st) + 2), dvs, mh, n, q); } while (0)
        for (int step = 0; step < 36; step += 2) { SCAN_STEP(L0, step); SCAN_STEP(L1, step + 1); }
#undef SCAN_STEP
    }
}

constexpr int RLEN = 4112, ZPITCH = 2056;
__device__ __forceinline__ void toeplitz(const Params& P, unsigned char* lds, int G, int bid, int tid) {
    unsigned char* ws = P.ws;
    const int lane = tid & 63, wave = tid >> 6, fr = lane & 15, fq = lane >> 4;
    const float* KF = (const float*)(ws + WS_KF); const float* KBk = (const float*)(ws + WS_KB); const float* NP = (const float*)(ws + WS_NP);
    const bf16* HYT = (const bf16*)(ws + WS_HY); bf16* YTo = (bf16*)(ws + WS_YT); const float* cw = P.in[9];
    bf16* R = (bf16*)lds;
    bf16* ZL = R + 8 * RLEN;
    float* red = (float*)(ZL + 16 * ZPITCH);
    for (int c = bid; c < 512; c += G) {
        float pv = 0.f;
        if (tid < 256) pv = NP[tid * 1024 + c] + NP[tid * 1024 + 512 + c];
        pv = wave_sum(pv);
        if (lane == 0) red[wave] = pv;
        float* C = (float*)ZL;
        { const f32x4 f = *(const f32x4*)(KF + (size_t)c * 2048 + 4 * tid), g = *(const f32x4*)(KBk + (size_t)c * 2048 + 4 * tid);
          *(f32x4*)(C + 2048 + 4 * tid) = f;
          if (tid > 0) C[2048 - 4 * tid] = g.x; else C[0] = 0.f;
          C[2047 - 4 * tid] = g.y; C[2046 - 4 * tid] = g.z; C[2045 - 4 * tid] = g.w; }
        __syncthreads();
        const float rnorm = 1.0f / (red[0] + red[1] + red[2] + red[3]);
        for (int e = tid; e < 8 * 514; e += 512) { const int o = e / 514, mg = e - o * 514; const int i0 = o + 4096 - 8 * mg;
            float v[8];
#pragma unroll
            for (int j = 0; j < 8; ++j) { const int idx = i0 - j; v[j] = (idx >= 0 && idx < 4096) ? C[idx] * rnorm : 0.f; }
            u32x4 w; w.x = pk2(v[0], v[1]); w.y = pk2(v[2], v[3]); w.z = pk2(v[4], v[5]); w.w = pk2(v[6], v[7]);
            *(u32x4*)(R + o * RLEN + 8 * mg) = w; }
        __syncthreads();
        {
            const float a0 = cw[512 + c], a1 = cw[1536 + 512 + c], a2 = cw[3072 + 512 + c], v0 = cw[1024 + c], v1 = cw[1536 + 1024 + c], v2 = cw[3072 + 1024 + c];
            const bf16* x1r = HYT + (size_t)(512 + c) * 32768; const bf16* vr = HYT + (size_t)(1024 + c) * 32768;
#pragma unroll 2
            for (int it = 0; it < 8; ++it) { const int e = it * 512 + tid, b = e >> 8, off = (e & 255) * 8; const size_t go = (size_t)b * SEQ + off;
                const u32x4 xa = *(const u32x4*)(x1r + go), va = *(const u32x4*)(vr + go);
                const float xlo = off > 0 ? bf2f(x1r[go - 1]) : 0.f, xhi = off + 8 < SEQ ? bf2f(x1r[go + 8]) : 0.f;
                const float vlo = off > 0 ? bf2f(vr[go - 1]) : 0.f, vhi = off + 8 < SEQ ? bf2f(vr[go + 8]) : 0.f;
                const float xs[10] = {xlo, bflo(xa.x), bfhi(xa.x), bflo(xa.y), bfhi(xa.y), bflo(xa.z), bfhi(xa.z), bflo(xa.w), bfhi(xa.w), xhi};
                const float vs[10] = {vlo, bflo(va.x), bfhi(va.x), bflo(va.y), bfhi(va.y), bflo(va.z), bfhi(va.z), bflo(va.w), bfhi(va.w), vhi};
                float z[8];
#pragma unroll
                for (int k = 0; k < 8; ++k) z[k] = (a0 * xs[k] + a1 * xs[k + 1] + a2 * xs[k + 2]) * (v0 * vs[k] + v1 * vs[k + 1] + v2 * vs[k + 2]);
                u32x4 w; w.x = pk2(z[0], z[1]); w.y = pk2(z[2], z[3]); w.z = pk2(z[4], z[5]); w.w = pk2(z[6], z[7]);
                *(u32x4*)(ZL + b * ZPITCH + off) = w; }
        }
        __syncthreads();
        f32x4 acc[16];
#pragma unroll
        for (int i = 0; i < 16; ++i) acc[i] = (f32x4){0.f, 0.f, 0.f, 0.f};
        const bf16* abase = R + wave * RLEN + 2048 - 8 * (fr - fq);
        const bf16* bbase = ZL + fr * ZPITCH + 8 * fq;
        for (int jr = 0; jr < 4; ++jr) {
            bf16x8 W[16];
#pragma unroll
            for (int dl = 0; dl < 16; ++dl) W[dl] = *(const bf16x8*)(abase - (128 * dl - 32 * jr));
#pragma unroll
            for (int jq = 0; jq < 16; ++jq) {
                if (jq > 0) W[(16 - jq) & 15] = *(const bf16x8*)(abase - (-128 * jq - 32 * jr));
                const bf16x8 Bv = *(const bf16x8*)(bbase + 32 * (4 * jq + jr));
#pragma unroll
                for (int i = 0; i < 16; ++i) acc[i] = __builtin_amdgcn_mfma_f32_16x16x32_bf16(W[(i - jq) & 15], Bv, acc[i], 0, 0, 0);
            }
        }
        __syncthreads();
        const float hb = P.in[17][c];
#pragma unroll
        for (int i = 0; i < 16; ++i)
#pragma unroll
            for (int ii = 0; ii < 4; ++ii) { const int t = 128 * i + wave + 8 * (4 * fq + ii); bf16* zp = ZL + fr * ZPITCH + t;
                *zp = (bf16)f2bf(acc[i][ii] + hb * bf2f(*zp)); }
        __syncthreads();
        {
            const float a0 = cw[c], a1 = cw[1536 + c], a2 = cw[3072 + c];
            const bf16* x0r = HYT + (size_t)c * 32768;
#pragma unroll 2
            for (int it = 0; it < 8; ++it) { const int e = it * 512 + tid, b = e >> 8, off = (e & 255) * 8; const size_t go = (size_t)b * SEQ + off;
                const u32x4 y = *(const u32x4*)(ZL + b * ZPITCH + off), xa = *(const u32x4*)(x0r + go);
                const float xlo = off > 0 ? bf2f(x0r[go - 1]) : 0.f, xhi = off + 8 < SEQ ? bf2f(x0r[go + 8]) : 0.f;
                const float xs[10] = {xlo, bflo(xa.x), bfhi(xa.x), bflo(xa.y), bfhi(xa.y), bflo(xa.z), bfhi(xa.z), bflo(xa.w), bfhi(xa.w), xhi};
                const float ys[8] = {bflo(y.x), bfhi(y.x), bflo(y.y), bfhi(y.y), bflo(y.z), bfhi(y.z), bflo(y.w), bfhi(y.w)};
                float o[8];
#pragma unroll
                for (int k = 0; k < 8; ++k) o[k] = ys[k] * (a0 * xs[k] + a1 * xs[k + 1] + a2 * xs[k + 2]);
                u32x4 w; w.x = pk2(o[0], o[1]); w.y = pk2(o[2], o[3]); w.z = pk2(o[4], o[5]); w.w = pk2(o[6], o[7]);
                *(u32x4*)(YTo + ((size_t)c * 16 + b) * SEQ + off) = w; }
        }
        __syncthreads();
    }
}

__device__ __forceinline__ void mixer_post(const Params& P, unsigned char* lds, int G, int bid, int tid) {
    unsigned char* ws = P.ws;
    const int lane = tid & 63, wave = tid >> 6;
    const bf16* YT = (const bf16*)(ws + WS_YT); bf16* YHY = (bf16*)(ws + WS_ACAT);
    unsigned* YLw = (unsigned*)lds;
    for (int u = bid; u < 512; u += G) {
        const int b = u >> 5, t0 = (u & 31) * 64;
        for (int it = 0; it < 32; ++it) { const int e = it * 512 + tid, row = e >> 5, w = e & 31;
            YLw[row * 33 + w] = ((const unsigned*)YT)[((size_t)(row * 16 + b) * SEQ + t0) / 2 + w]; }
        __syncthreads();
        const bf16* YL = (const bf16*)YLw;
        for (int i = 0; i < 64; ++i) YHY[(size_t)(b * SEQ + t0 + i) * 1024 + tid] = YL[tid * 66 + i];
        __syncthreads();
    }
    const bf16* INTRA = (const bf16*)(ws + WS_INTRA); const bf16* INTF = (const bf16*)(ws + WS_INTF); const bf16* INTB = (const bf16*)(ws + WS_INTB);
    const bf16* QR = (const bf16*)(ws + WS_QR); bf16* YGLA = (bf16*)(ws + WS_ACAT) + 512;
    const float* gw_ = P.in[22];
    const f32x4 nw0 = *(const f32x4*)(gw_ + 8 * lane), nw1 = *(const f32x4*)(gw_ + 8 * lane + 4);
    const float nw[8] = {nw0.x, nw0.y, nw0.z, nw0.w, nw1.x, nw1.y, nw1.z, nw1.w};
    for (int m = bid * 8 + wave; m < MTOK; m += G * 8) {
        const size_t o8 = (size_t)m * 512 + 8 * lane;
        const u32x4 a = *(const u32x4*)(INTRA + o8), f = *(const u32x4*)(INTF + o8), g = *(const u32x4*)(INTB + o8), r = *(const u32x4*)(QR + (size_t)m * 768 + 256 + 8 * lane);
        float o[8] = {bflo(a.x) + bflo(f.x) + bflo(g.x), bfhi(a.x) + bfhi(f.x) + bfhi(g.x), bflo(a.y) + bflo(f.y) + bflo(g.y), bfhi(a.y) + bfhi(f.y) + bfhi(g.y),
                      bflo(a.z) + bflo(f.z) + bflo(g.z), bfhi(a.z) + bfhi(f.z) + bfhi(g.z), bflo(a.w) + bflo(f.w) + bflo(g.w), bfhi(a.w) + bfhi(f.w) + bfhi(g.w)};
        const float rr[8] = {bflo(r.x), bfhi(r.x), bflo(r.y), bfhi(r.y), bflo(r.z), bfhi(r.z), bflo(r.w), bfhi(r.w)};
        float ss = 0.f;
#pragma unroll
        for (int j = 0; j < 8; ++j) ss += o[j] * o[j];
        ss += __shfl_xor(ss, 1); ss += __shfl_xor(ss, 2); ss += __shfl_xor(ss, 4); ss += __shfl_xor(ss, 8);
        const float rstd = rsqrtf(ss * (1.f / 128.f) + EPS);
        float y[8];
#pragma unroll
        for (int j = 0; j < 8; ++j) y[j] = o[j] * rstd * nw[j] * silu_f(rr[j]);
        u32x4 w; w.x = pk2(y[0], y[1]); w.y = pk2(y[2], y[3]); w.z = pk2(y[4], y[5]); w.w = pk2(y[6], y[7]);
        *(u32x4*)(YGLA + (size_t)m * 1024 + 8 * lane) = w;
    }
}

typedef float f32x2 __attribute__((ext_vector_type(2)));
struct G8 { f32x2 v[4]; };
__device__ __forceinline__ u32x4 ldg_mask(const bf16* p, bool ok) { u32x4 g = {0u, 0u, 0u, 0u}; if (ok) g = *(const u32x4*)p; return g; }
__device__ __forceinline__ G8 unpack8(const u32x4 g) { G8 r; r.v[0] = (f32x2){bflo(g.x), bfhi(g.x)}; r.v[1] = (f32x2){bflo(g.y), bfhi(g.y)}; r.v[2] = (f32x2){bflo(g.z), bfhi(g.z)}; r.v[3] = (f32x2){bflo(g.w), bfhi(g.w)}; return r; }
__device__ __forceinline__ void dwconv(const Params& P, int G, int bid, int tid, const bool real = true) {
    unsigned char* ws = P.ws;
    const int lane = tid & 63, wave = tid >> 6;
    const bf16* GATE = (const bf16*)(ws + WS_GATE); bf16* UP = (bf16*)(ws + WS_UP);
    const float* dw = P.in[27]; const float* dwb = P.in[28];
    const int gw = bid * 8 + wave, NGW = G * 8, nper = NGW / 11;
    if (gw >= nper * 11) return;
    const int cb = gw % 11, k0 = gw / 11;
    const int x0 = 32 * (lane >> 5), c0 = cb * 256 + (lane & 31) * 8;
    f32x2 wt[9][4], bs[4];
#pragma unroll
    for (int tp = 0; tp < 9; ++tp) { const f32x4 a = *(const f32x4*)(dw + tp * FFH + c0), b = *(const f32x4*)(dw + tp * FFH + c0 + 4);
        wt[tp][0] = (f32x2){a.x, a.y}; wt[tp][1] = (f32x2){a.z, a.w}; wt[tp][2] = (f32x2){b.x, b.y}; wt[tp][3] = (f32x2){b.z, b.w}; }
    { const f32x4 a = *(const f32x4*)(dwb + c0), b = *(const f32x4*)(dwb + c0 + 4); bs[0] = (f32x2){a.x, a.y}; bs[1] = (f32x2){a.z, a.w}; bs[2] = (f32x2){b.x, b.y}; bs[3] = (f32x2){b.z, b.w}; }
    for (int rowid = k0; rowid < 512; rowid += nper) {
        const int b = rowid >> 5, y = rowid & 31;
        const bf16* grow[3]; bool rok[3];
#pragma unroll
        for (int d = 0; d < 3; ++d) { const int yy = y + d - 1; rok[d] = yy >= 0 && yy <= 31; grow[d] = GATE + (size_t)(b * SEQ + (rok[d] ? yy : y) * 64) * FFH + c0; }
        bf16* urow = UP + (size_t)(b * SEQ + y * 64) * FFH + c0;
        G8 prv[3], cur[3];
#pragma unroll
        for (int d = 0; d < 3; ++d) { prv[d] = unpack8(ldg_mask(grow[d] + (size_t)(x0 - 1) * FFH, rok[d] && x0 > 0)); cur[d] = unpack8(ldg_mask(grow[d] + (size_t)x0 * FFH, rok[d])); }
        for (int xs = 0; xs < 32; xs += 2) {
            u32x4 nraw[2][3], uv[2];
#pragma unroll
            for (int k = 0; k < 2; ++k) { const int xn = x0 + xs + k + 1;
#pragma unroll
                for (int d = 0; d < 3; ++d) nraw[k][d] = ldg_mask(grow[d] + (size_t)xn * FFH, rok[d] && xn <= 63);
                uv[k] = *(const u32x4*)(urow + (size_t)(x0 + xs + k) * FFH); }
#pragma unroll
            for (int k = 0; k < 2; ++k) {
                G8 nxt[3];
#pragma unroll
                for (int d = 0; d < 3; ++d) nxt[d] = unpack8(nraw[k][d]);
                f32x2 acc[4];
#pragma unroll
                for (int j = 0; j < 4; ++j) acc[j] = bs[j];
#pragma unroll
                for (int d = 0; d < 3; ++d)
#pragma unroll
                    for (int j = 0; j < 4; ++j) acc[j] += prv[d].v[j] * wt[d * 3 + 0][j] + cur[d].v[j] * wt[d * 3 + 1][j] + nxt[d].v[j] * wt[d * 3 + 2][j];
                const G8 u8 = unpack8(uv[k]);
                unsigned wv[4];
#pragma unroll
                for (int j = 0; j < 4; ++j) { const float e0 = __expf(-acc[j].x), e1 = __expf(-acc[j].y);
                    const float s0 = acc[j].x * __builtin_amdgcn_rcpf(1.0f + e0), s1 = acc[j].y * __builtin_amdgcn_rcpf(1.0f + e1);
                    wv[j] = pk2(s0 * u8.v[j].x, s1 * u8.v[j].y); }
                u32x4 w; w.x = wv[0]; w.y = wv[1]; w.z = wv[2]; w.w = wv[3];
                if (real || (w.x == 0x12345678u && w.y == 0x9abcdef0u)) *(u32x4*)(urow + (size_t)(x0 + xs + k) * FFH) = w;
#pragma unroll
                for (int d = 0; d < 3; ++d) { prv[d] = cur[d]; cur[d] = nxt[d]; }
            }
        }
    }
}

#define XB_TMO      128
#define XB_XCNT(j)  (256  + 64 * (j))
#define XB_XSUB(j)  (1280 + 64 * (j))
#define XB_XGEN(j)  (2304 + 64 * (j))
#define XB_TOP      3328
#define XB_TOPGEN   3392
#define XCD_BAR_WORDS 3456
#define XB_SPIN_CAP (1u << 18)

__device__ __forceinline__ unsigned xb_ld(unsigned* p)              { return __hip_atomic_load(p, __ATOMIC_RELAXED, __HIP_MEMORY_SCOPE_AGENT); }
__device__ __forceinline__ unsigned xb_add(unsigned* p, unsigned v) { return __hip_atomic_fetch_add(p, v, __ATOMIC_RELAXED, __HIP_MEMORY_SCOPE_AGENT); }
__device__ __forceinline__ unsigned xb_xcc_id() { return (unsigned)__builtin_amdgcn_s_getreg((3 << 11) | 20) & 0xFu; }
#define XB_SPIN(cond, bar) do { unsigned _sp = 0; while (cond) { __builtin_amdgcn_s_sleep(1); \
    if ((++_sp & 255u) == 0u) { if (xb_ld(&(bar)[XB_TMO])) break; if (_sp > XB_SPIN_CAP) { atomicAdd(&(bar)[XB_TMO], 1u); break; } } } } while (0)

struct XcdBarrier {
    unsigned* bar; unsigned x;
    volatile LAS unsigned* st;
};

__device__ __forceinline__ XcdBarrier xcd_barrier_post(unsigned* bar, volatile LAS unsigned* st) {
    XcdBarrier b; b.bar = bar; b.x = xb_xcc_id(); b.st = st;
    if (threadIdx.x == 0) (void)xb_add(&bar[XB_XCNT(b.x)], 1u);
    return b;
}
__device__ __forceinline__ void xcd_barrier_complete(unsigned* bar, unsigned x, unsigned& nloc, unsigned& nx) {
    const unsigned G = gridDim.x * gridDim.y * gridDim.z;
    unsigned sum, cnt, mine, sp = 0u;
    for (;;) {
        sum = 0u; cnt = 0u; mine = 0u;
#pragma unroll
        for (unsigned j = 0; j < 16; ++j) { const unsigned c = xb_ld(&bar[XB_XCNT(j)]); sum += c; cnt += (c > 0u) ? 1u : 0u; mine = (j == x) ? c : mine; }
        if (sum == G) break;
        __builtin_amdgcn_s_sleep(1);
        if ((++sp & 255u) == 0u) { if (xb_ld(&bar[XB_TMO])) break; if (sp > XB_SPIN_CAP) { atomicAdd(&bar[XB_TMO], 1u); break; } }
    }
    nloc = mine > 0u ? mine : 1u; nx = cnt > 0u ? cnt : 1u;
}

__device__ __forceinline__ void xcd_barrier(const XcdBarrier& b) {
    asm volatile("s_waitcnt vmcnt(0)" ::: "memory");
    __syncthreads();
    if (threadIdx.x == 0) {
        unsigned* bar = b.bar;
        __builtin_amdgcn_s_waitcnt(0);
        unsigned nloc = b.st[0], nx = b.st[1];
        if (nloc == 0u) { xcd_barrier_complete(bar, b.x, nloc, nx); b.st[0] = nloc; b.st[1] = nx; }
        const unsigned old = xb_add(&bar[XB_XSUB(b.x)], 1u);
        const unsigned gen = old / nloc;
        if (old + 1u == (gen + 1u) * nloc) {
            __builtin_amdgcn_fence(__ATOMIC_RELEASE, "agent");
            asm volatile("s_waitcnt vmcnt(0)" ::: "memory");
            const unsigned og = xb_add(&bar[XB_TOP], 1u);
            const unsigned tg = og / nx;
            if (og + 1u == (tg + 1u) * nx) xb_add(&bar[XB_TOPGEN], 1u);
            else XB_SPIN(xb_ld(&bar[XB_TOPGEN]) == tg, bar);
            __builtin_amdgcn_fence(__ATOMIC_ACQUIRE, "agent");
            xb_add(&bar[XB_XGEN(b.x)], 1u);
            asm volatile("s_waitcnt vmcnt(0)" ::: "memory");
        } else {
            XB_SPIN(xb_ld(&bar[XB_XGEN(b.x)]) == gen, bar);
            __builtin_amdgcn_fence(__ATOMIC_ACQUIRE, "agent");
            asm volatile("s_waitcnt vmcnt(0)" ::: "memory");
        }
    }
    __syncthreads();
}

__global__ void __launch_bounds__(512, 2) fwd_megakernel(Params P) {
    extern __shared__ __attribute__((aligned(16))) unsigned char lds[];
    cg::grid_group grid = cg::this_grid();
    const int G = gridDim.x, bid = blockIdx.x, tid = threadIdx.x;
    unsigned char* ws = P.ws;
    PG8_LAS unsigned char* glds = (PG8_LAS unsigned char*)lds;
    volatile LAS unsigned* bst = (volatile LAS unsigned*)(glds + LDS_BYTES - 16);
    if (tid < 4) bst[tid] = 0u;
    __syncthreads();
    XcdBarrier xb = xcd_barrier_post((unsigned*)ws, bst);
#define GSYNC() xcd_barrier(xb)

    phase0(P, lds, G, bid, tid);
    if (P.ws == nullptr) grid.sync();
    GSYNC();
    phase1(P, lds, G, bid, tid);
    GSYNC();
    {
        pg8::Gemm g{(const pg8::bf16_t*)(ws + WS_XN), (const pg8::bf16_t*)(ws + WS_WIN), MALL, NPROJ, 1024};
        pg8::ProjOrder S; S.init(G, bid);
        pg8::EpiProj E{(pg8::bf16_t*)(ws + WS_KVA), (pg8::bf16_t*)(ws + WS_HY), (pg8::bf16_t*)(ws + WS_QR), (pg8::bf16_t*)(ws + WS_GATES)};
        pg8::gemm_phase<pg8::EpiProj, pg8::ProjOrder, true, true>(glds, g, S, E);
    }
    GSYNC();
    gla_pre(P, lds, G, bid, tid);
    GSYNC();
    gla_scan(P, G, bid, tid);
    toeplitz(P, lds, G, bid, tid);
    GSYNC();
    mixer_post(P, lds, G, bid, tid);
    GSYNC();
    {
        pg8::StaticOrder S; S.init(MTOK, 1024, G, bid);
        pg8::Gemm g{(const pg8::bf16_t*)(ws + WS_ACAT), (const pg8::bf16_t*)(ws + WS_WHP), MTOK, 1024, 1024};
        pg8::EpiGateFused E{(const pg8::bf16_t*)(ws + WS_GATES), (pg8::bf16_t*)(ws + WS_MERGED)};
        pg8::gemm_phase<pg8::EpiGateFused, pg8::StaticOrder, true, true>(glds, g, S, E);
    }
    GSYNC();
    {
        pg8::StaticOrder S; S.init(MTOK, 1024, G, bid);
        pg8::Gemm g{(const pg8::bf16_t*)(ws + WS_MERGED), (const pg8::bf16_t*)(ws + WS_WOUT), MTOK, 1024, 1024};
        pg8::EpiResNorm<0> E{P.in[0], P.out, (const float*)(ws + WS_MOD) + 2048, (float*)(ws + WS_ROWSS_A), (unsigned*)(ws + WS_CNT_A), P.in[7], (const float*)(ws + WS_MOD), (pg8::bf16_t*)(ws + WS_H2), (unsigned*)(ws + WS_TMO)};
        pg8::gemm_phase<pg8::EpiResNorm<0>, pg8::StaticOrder, true, true>(glds, g, S, E);
    }
    GSYNC();
    {
        pg8::StaticOrder S; S.init(MTOK, 2 * FFH, G, bid);
        pg8::Gemm g{(const pg8::bf16_t*)(ws + WS_H2), (const pg8::bf16_t*)(ws + WS_WFI), MTOK, 2 * FFH, 1024};
        pg8::EpiSplit E{(pg8::bf16_t*)(ws + WS_UP), (pg8::bf16_t*)(ws + WS_GATE), 11, FFH};
        pg8::gemm_phase<pg8::EpiSplit, pg8::StaticOrder, true, true>(glds, g, S, E);
    }
    GSYNC();
    dwconv(P, G, bid, tid);
    GSYNC();
    {
        pg8::StaticOrder S; S.init(MTOK, 1024, G, bid);
        pg8::Gemm g{(const pg8::bf16_t*)(ws + WS_UP), (const pg8::bf16_t*)(ws + WS_WFO), MTOK, 1024, FFH};
        pg8::EpiResNorm<1> E{P.out, P.out, (const float*)(ws + WS_MOD) + 5120, (float*)(ws + WS_ROWSS_B), (unsigned*)(ws + WS_CNT_B), P.in[30], (const float*)(ws + WS_MOD), nullptr, (unsigned*)(ws + WS_TMO)};
        pg8::gemm_phase<pg8::EpiResNorm<1>, pg8::StaticOrder, true, true>(glds, g, S, E);
    }
}

extern "C" void kernel_launch(void* const* d_in, const int* in_sizes, int n_in, void* d_out, int out_size, void* d_ws, size_t ws_size, hipStream_t stream) {
    static int grid = 0;
    if (grid == 0) {
        if (n_in != 31 || out_size != MTOK * DM || ws_size < WS_NEED) { fprintf(stderr, "kernel_launch: unexpected shapes: n_in %d out %d ws %zu (need %zu)\n", n_in, out_size, ws_size, (size_t)WS_NEED); grid = -1; return; }
        int dev = 0, cus = 0, per_cu = 0;
        hipGetDevice(&dev);
        hipDeviceGetAttribute(&cus, hipDeviceAttributeMultiprocessorCount, dev);
        if (hipFuncSetAttribute((const void*)fwd_megakernel, hipFuncAttributeMaxDynamicSharedMemorySize, LDS_BYTES) != hipSuccess) { fprintf(stderr, "kernel_launch: hipFuncSetAttribute failed\n"); grid = -1; return; }
        if (hipOccupancyMaxActiveBlocksPerMultiprocessor(&per_cu, (const void*)fwd_megakernel, 512, LDS_BYTES) != hipSuccess || per_cu < 1) { fprintf(stderr, "kernel_launch: occupancy query failed (%d)\n", per_cu); per_cu = 1; }
        (void)hipGetLastError();
        grid = cus * 1;
        fprintf(stderr, "kernel_launch: cus %d per_cu %d grid %d\n", cus, per_cu, grid);
    }
    if (grid < 0) return;
    Params p{};
    for (int i = 0; i < 31; ++i) p.in[i] = (const float*)d_in[i];
    p.out = (float*)d_out; p.ws = (unsigned char*)d_ws;
    if (hipMemsetAsync(d_ws, 0, WS_ZERO_BYTES, stream) != hipSuccess) { fprintf(stderr, "kernel_launch: memset failed\n"); return; }
    void* args[] = {&p};
    hipError_t e = hipLaunchCooperativeKernel((const void*)fwd_megakernel, dim3(grid), dim3(512), args, LDS_BYTES, stream);
    if (e != hipSuccess) fprintf(stderr, "kernel_launch: cooperative launch failed: %s (grid %d)\n", hipGetErrorString(e), grid);
}
```

```cpp
#include <hip/hip_runtime.h>
#include <hip/hip_cooperative_groups.h>
#include <cstdio>
#include <cstdint>
namespace cg = cooperative_groups;
namespace pg8 {
#define PG8_LAS __attribute__((address_space(3)))
typedef unsigned short bf16_t;
typedef short bf16x8 __attribute__((ext_vector_type(8)));
typedef float f32x4 __attribute__((ext_vector_type(4)));
typedef unsigned u32x4 __attribute__((ext_vector_type(4)));
typedef unsigned u32x2 __attribute__((ext_vector_type(2)));
constexpr int BM = 256, BK = 64, HALF = 128, HTB = HALF * BK * 2  , STAGE_BYTES = 8 * HTB, NXCD = 8, WGM = 8;

__host__ __device__ __forceinline__ int lds_byte(int r, int c) { const int st = (r >> 4) * 2 + (c >> 5), rr = r & 15, cc = c & 31, ob = rr * 64 + cc * 2; return st * 1024 + (ob ^ (((ob >> 9) & 1) << 5)); }
__host__ __device__ __forceinline__ void stage_rc(int b, int& R, int& C) { const int st = b / 1024, sb = b % 1024, swz = sb ^ (((sb >> 9) & 1) << 5); R = (st >> 1) * 16 + swz / 64; C = (st & 1) * 32 + (swz % 64) / 2; }
__host__ __device__ __forceinline__ int perm32(int rho) { const int n = rho >> 4, i = rho & 15; return 8 * (i >> 2) + 4 * n + (i & 3); }

struct Unit { int pm, pn; };
struct Gemm { const bf16_t* A; const bf16_t* Bt; int M, N, K; };

struct StaticOrder {
    int nM, nN, nwg, G, c;
    __host__ __device__ void init(int M, int N, int G_, int c_) { nM = M / BM; nN = N / BM; nwg = nM * nN; G = G_; c = c_; }
    __host__ __device__ bool next(int i, Unit& u) const {
        const long L = (long)i * G + c; if (L >= nwg) return false;
        int wgid = (int)L; { const int q = nwg / NXCD, r = nwg % NXCD, xcd = wgid % NXCD, off = wgid / NXCD; wgid = (xcd < r ? xcd * (q + 1) : r * (q + 1) + (xcd - r) * q) + off; }
        const int nig = WGM * nN, gid = wgid / nig, fm = gid * WGM, gsz = (nM - fm) < WGM ? (nM - fm) : WGM;
        u.pm = fm + ((wgid % nig) % gsz); u.pn = (wgid % nig) / gsz; return true;
    }
    __device__ __forceinline__ void a_ready(const Unit&) const {}
    __device__ __forceinline__ void done(const Unit&) const {}
};

__device__ __forceinline__ unsigned cvt_pk_bf16(float lo, float hi) { unsigned r; asm volatile("v_cvt_pk_bf16_f32 %0, %1, %2" : "=v"(r) : "v"(lo), "v"(hi)); return r; }
typedef float f32x2 __attribute__((ext_vector_type(2)));
__device__ __forceinline__ f32x2 gelu_pk(f32x2 v) {
    const f32x2 av = __builtin_elementwise_abs(v), d = av * 0.2316418882f + 1.0f;
    f32x2 t; t.x = __builtin_amdgcn_rcpf(d.x); t.y = __builtin_amdgcn_rcpf(d.y);
    f32x2 q = t * 0.5307027145f + (-0.7265760135f); q = q * t + 0.7107068705f; q = q * t + (-0.142248368f); q = q * t + 0.127414796f; q = q * t;
    const f32x2 s = (v * v) * (-0.72134752044f);
    f32x2 e; e.x = __builtin_amdgcn_exp2f(s.x); e.y = __builtin_amdgcn_exp2f(s.y);
    const f32x2 m = v * (q * e), r = v - m;
    f32x2 o; o.x = v.x < 0.f ? m.x : r.x; o.y = v.y < 0.f ? m.y : r.y; return o;
}

template <int ACT  > struct EpiBf16 {
    static constexpr bool PERM = true, AFTER_DRAIN = false; static constexpr int MIDK = 0; static_assert(ACT == 0 || ACT == 1, "EpiBf16: ACT is 0 (none) or 1 (gelu_pk)");
    bf16_t* O; int ldc; const float* bias; int split_cols; size_t split_stride; float scale0;
    __device__ __forceinline__ void operator()(const f32x4 (&acc)[2][2][4][2], const Unit& u, int wr, int wc, int fr, int fq) const {
        const int row0 = u.pm * BM + wr * 64 + fr; int colt = u.pn * BM; bf16_t* base = O;
        float sc = 1.f; if (split_cols) { const int t = colt / split_cols; base += (size_t)t * split_stride; colt -= t * split_cols; if (t == 0) sc = scale0; }
        const int col0 = colt + wc * 32 + 8 * fq, bcol0 = u.pn * BM + wc * 32 + 8 * fq;
        f32x4 bv[2][2];
#pragma unroll
        for (int bj = 0; bj < 2; ++bj)
#pragma unroll
            for (int n = 0; n < 2; ++n) bv[bj][n] = bias ? *(const f32x4*)(bias + bcol0 + bj * HALF + 4 * n) : (f32x4){0.f, 0.f, 0.f, 0.f};
#pragma unroll
        for (int ai = 0; ai < 2; ++ai)
#pragma unroll
            for (int m = 0; m < 4; ++m) { bf16_t* rowp = base + (size_t)(row0 + ai * HALF + m * 16) * ldc + col0;
#pragma unroll
                for (int bj = 0; bj < 2; ++bj) { f32x4 v0 = acc[ai][bj][m][0] + bv[bj][0], v1 = acc[ai][bj][m][1] + bv[bj][1];
                    if (ACT == 1) { f32x2 a = gelu_pk((f32x2){v0[0], v0[1]}), b = gelu_pk((f32x2){v0[2], v0[3]}), c = gelu_pk((f32x2){v1[0], v1[1]}), d = gelu_pk((f32x2){v1[2], v1[3]});
                        v0 = (f32x4){a.x, a.y, b.x, b.y}; v1 = (f32x4){c.x, c.y, d.x, d.y}; }
                    v0 = v0 * sc; v1 = v1 * sc; u32x4 w; w.x = cvt_pk_bf16(v0[0], v0[1]); w.y = cvt_pk_bf16(v0[2], v0[3]); w.z = cvt_pk_bf16(v1[0], v1[1]); w.w = cvt_pk_bf16(v1[2], v1[3]);
                    *(u32x4*)(rowp + bj * HALF) = w; } }
    }
};
struct ProjOrder {
    StaticOrder so; int G, c;
    __host__ __device__ void init(int G_, int c_) { so.init(32768, 5376, G_, c_); G = G_; c = c_; }
    __host__ __device__ bool next(int i, Unit& u) const {
        const long L = (long)i * G + c;
        if (L < so.nwg) return so.next(i, u);
        const int j = (int)(L - so.nwg); if (j >= 64) return false;
        u.pm = 128 + (j >> 2); u.pn = j & 3; return true;
    }
    __device__ __forceinline__ void a_ready(const Unit&) const {}
    __device__ __forceinline__ void done(const Unit&) const {}
};
__device__ __forceinline__ float bflo(unsigned w) { return __uint_as_float(w << 16); }
__device__ __forceinline__ float bfhi(unsigned w) { return __uint_as_float(w & 0xffff0000u); }
__device__ __forceinline__ float sigm(float x) { return 1.0f / (1.0f + __expf(-x)); }

struct EpiProj {
    static constexpr bool PERM = true, AFTER_DRAIN = false; static constexpr int MIDK = 0;
    bf16_t *kva, *hy, *qr, *gates;
    __device__ __forceinline__ void operator()(const f32x4 (&acc)[2][2][4][2], const Unit& u, int wr, int wc, int fr, int fq) const {
        bf16_t* base; int ldc, colt; const int pn = u.pn;
        if (pn < 4) { base = kva; ldc = 1024; colt = pn * 256; }
        else if (pn < 10) {
            const int row0t = u.pm * BM + wr * 64 + fr, c0t = (pn - 4) * 256 + wc * 32 + 8 * fq;
#pragma unroll
            for (int ai = 0; ai < 2; ++ai)
#pragma unroll
                for (int bj = 0; bj < 2; ++bj) {
                    unsigned W[4][4];
#pragma unroll
                    for (int m = 0; m < 4; ++m) { const f32x4 v0 = acc[ai][bj][m][0], v1 = acc[ai][bj][m][1];
                        W[m][0] = cvt_pk_bf16(v0[0], v0[1]); W[m][1] = cvt_pk_bf16(v0[2], v0[3]); W[m][2] = cvt_pk_bf16(v1[0], v1[1]); W[m][3] = cvt_pk_bf16(v1[2], v1[3]); }
                    bf16_t* cp = hy + (size_t)(c0t + bj * HALF) * 32768 + (row0t + ai * HALF);
#pragma unroll
                    for (int k = 0; k < 4; ++k) {
#pragma unroll
                        for (int m = 0; m < 4; ++m) cp[(size_t)(2 * k) * 32768 + m * 16] = (bf16_t)(W[m][k] & 0xffffu);
#pragma unroll
                        for (int m = 0; m < 4; ++m) cp[(size_t)(2 * k + 1) * 32768 + m * 16] = (bf16_t)(W[m][k] >> 16); } }
            return; }
        else if (pn < 13) { base = qr; ldc = 768; colt = (pn - 10) * 256; }
        else { base = gates; ldc = 2048; colt = (pn - 13) * 256; }
        const int row0 = u.pm * BM + wr * 64 + fr, col0 = colt + wc * 32 + 8 * fq;
#pragma unroll
        for (int ai = 0; ai < 2; ++ai)
#pragma unroll
            for (int m = 0; m < 4; ++m) { bf16_t* rowp = base + (size_t)(row0 + ai * HALF + m * 16) * ldc + col0;
#pragma unroll
                for (int bj = 0; bj < 2; ++bj) { const f32x4 v0 = acc[ai][bj][m][0], v1 = acc[ai][bj][m][1];
                    u32x4 w; w.x = cvt_pk_bf16(v0[0], v0[1]); w.y = cvt_pk_bf16(v0[2], v0[3]); w.z = cvt_pk_bf16(v1[0], v1[1]); w.w = cvt_pk_bf16(v1[2], v1[3]);
                    *(u32x4*)(rowp + bj * HALF) = w; } }
    }
};
struct EpiSplit {
    static constexpr bool PERM = true, AFTER_DRAIN = false; static constexpr int MIDK = 0;
    bf16_t *o0, *o1; int nsplit, ldc;
    __device__ __forceinline__ void operator()(const f32x4 (&acc)[2][2][4][2], const Unit& u, int wr, int wc, int fr, int fq) const {
        bf16_t* base = u.pn < nsplit ? o0 : o1; const int colt = (u.pn < nsplit ? u.pn : u.pn - nsplit) * 256;
        const int row0 = u.pm * BM + wr * 64 + fr, col0 = colt + wc * 32 + 8 * fq;
#pragma unroll
        for (int ai = 0; ai < 2; ++ai)
#pragma unroll
            for (int m = 0; m < 4; ++m) { bf16_t* rowp = base + (size_t)(row0 + ai * HALF + m * 16) * ldc + col0;
#pragma unroll
                for (int bj = 0; bj < 2; ++bj) { const f32x4 v0 = acc[ai][bj][m][0], v1 = acc[ai][bj][m][1];
                    u32x4 w; w.x = cvt_pk_bf16(v0[0], v0[1]); w.y = cvt_pk_bf16(v0[2], v0[3]); w.z = cvt_pk_bf16(v1[0], v1[1]); w.w = cvt_pk_bf16(v1[2], v1[3]);
                    *(u32x4*)(rowp + bj * HALF) = w; } }
    }
};
template <int SECOND> struct EpiGate {
    static constexpr bool PERM = true, AFTER_DRAIN = false; static constexpr int MIDK = 0;
    const bf16_t* gates; bf16_t* merged;
    __device__ __forceinline__ void operator()(const f32x4 (&acc)[2][2][4][2], const Unit& u, int wr, int wc, int fr, int fq) const {
        const int row0 = u.pm * BM + wr * 64 + fr, col0 = u.pn * BM + wc * 32 + 8 * fq;
#pragma unroll
        for (int ai = 0; ai < 2; ++ai)
#pragma unroll
            for (int m = 0; m < 4; ++m) { const size_t row = (size_t)(row0 + ai * HALF + m * 16);
#pragma unroll
                for (int bj = 0; bj < 2; ++bj) { const int col = col0 + bj * HALF;
                    const u32x4 g = *(const u32x4*)(gates + row * 2048 + SECOND * 1024 + col);
                    const f32x4 a0 = acc[ai][bj][m][0], a1 = acc[ai][bj][m][1];
                    float v[8];
                    v[0] = sigm(bflo(g.x)) * a0[0]; v[1] = sigm(bfhi(g.x)) * a0[1]; v[2] = sigm(bflo(g.y)) * a0[2]; v[3] = sigm(bfhi(g.y)) * a0[3];
                    v[4] = sigm(bflo(g.z)) * a1[0]; v[5] = sigm(bfhi(g.z)) * a1[1]; v[6] = sigm(bflo(g.w)) * a1[2]; v[7] = sigm(bfhi(g.w)) * a1[3];
                    bf16_t* mp = merged + row * 1024 + col;
                    if (SECOND) { const u32x4 p = *(const u32x4*)mp;
                        v[0] += bflo(p.x); v[1] += bfhi(p.x); v[2] += bflo(p.y); v[3] += bfhi(p.y); v[4] += bflo(p.z); v[5] += bfhi(p.z); v[6] += bflo(p.w); v[7] += bfhi(p.w); }
                    u32x4 w; w.x = cvt_pk_bf16(v[0], v[1]); w.y = cvt_pk_bf16(v[2], v[3]); w.z = cvt_pk_bf16(v[4], v[5]); w.w = cvt_pk_bf16(v[6], v[7]);
                    *(u32x4*)mp = w; } }
    }
};
struct EpiRes {
    static constexpr bool PERM = true, AFTER_DRAIN = false; static constexpr int MIDK = 0;
    const float* base; float* out; const float* gate;
    __device__ __forceinline__ void operator()(const f32x4 (&acc)[2][2][4][2], const Unit& u, int wr, int wc, int fr, int fq) const {
        const int row0 = u.pm * BM + wr * 64 + fr, col0 = u.pn * BM + wc * 32 + 8 * fq;
        const float* gp = gate + (size_t)(u.pm >> 3) * 6144 + col0;
        f32x4 gv[2][2];
#pragma unroll
        for (int bj = 0; bj < 2; ++bj)
#pragma unroll
            for (int n = 0; n < 2; ++n) gv[bj][n] = *(const f32x4*)(gp + bj * HALF + 4 * n);
#pragma unroll
        for (int ai = 0; ai < 2; ++ai)
#pragma unroll
            for (int m = 0; m < 4; ++m) { const size_t off = (size_t)(row0 + ai * HALF + m * 16) * 1024 + col0;
#pragma unroll
                for (int bj = 0; bj < 2; ++bj)
#pragma unroll
                    for (int n = 0; n < 2; ++n) { const f32x4 bs = *(const f32x4*)(base + off + bj * HALF + 4 * n);
                        *(f32x4*)(out + off + bj * HALF + 4 * n) = bs + gv[bj][n] * acc[ai][bj][m][n]; } }
    }
};

struct EpiGateFused {
    static constexpr bool PERM = true, AFTER_DRAIN = false; static constexpr int MIDK = 8;
    const bf16_t* gates; bf16_t* merged;
    __device__ __forceinline__ void mid(f32x4 (&acc)[2][2][4][2], const Unit& u, int wr, int wc, int fr, int fq) const {
        int row0 = u.pm * BM + wr * 64 + fr, col0 = u.pn * BM + wc * 32 + 8 * fq;
        asm volatile("" : "+v"(row0), "+v"(col0));
#pragma unroll
        for (int ai = 0; ai < 2; ++ai)
#pragma unroll
            for (int m = 0; m < 4; ++m) { const size_t row = (size_t)(row0 + ai * HALF + m * 16);
#pragma unroll
                for (int bj = 0; bj < 2; ++bj) { const int col = col0 + bj * HALF;
                    const u32x4 gh = *(const u32x4*)(gates + row * 2048 + col), gg = *(const u32x4*)(gates + row * 2048 + 1024 + col);
                    const float h[8] = {bflo(gh.x), bfhi(gh.x), bflo(gh.y), bfhi(gh.y), bflo(gh.z), bfhi(gh.z), bflo(gh.w), bfhi(gh.w)};
                    const float g[8] = {bflo(gg.x), bfhi(gg.x), bflo(gg.y), bfhi(gg.y), bflo(gg.z), bfhi(gg.z), bflo(gg.w), bfhi(gg.w)};
#pragma unroll
                    for (int j = 0; j < 8; ++j) { const float r = (1.0f + __expf(-g[j])) * __builtin_amdgcn_rcpf(1.0f + __expf(-h[j])); acc[ai][bj][m][j >> 2][j & 3] *= r; } }
                if (m == 3) asm volatile("" ::: "memory"); }
    }
    __device__ __forceinline__ void operator()(const f32x4 (&acc)[2][2][4][2], const Unit& u, int wr, int wc, int fr, int fq) const {
        const int row0 = u.pm * BM + wr * 64 + fr, col0 = u.pn * BM + wc * 32 + 8 * fq;
#pragma unroll
        for (int ai = 0; ai < 2; ++ai)
#pragma unroll
            for (int m = 0; m < 4; ++m) { const size_t row = (size_t)(row0 + ai * HALF + m * 16);
#pragma unroll
                for (int bj = 0; bj < 2; ++bj) { const int col = col0 + bj * HALF;
                    const u32x4 g = *(const u32x4*)(gates + row * 2048 + 1024 + col);
                    const f32x4 a0 = acc[ai][bj][m][0], a1 = acc[ai][bj][m][1];
                    u32x4 w; w.x = cvt_pk_bf16(sigm(bflo(g.x)) * a0[0], sigm(bfhi(g.x)) * a0[1]); w.y = cvt_pk_bf16(sigm(bflo(g.y)) * a0[2], sigm(bfhi(g.y)) * a0[3]);
                    w.z = cvt_pk_bf16(sigm(bflo(g.z)) * a1[0], sigm(bfhi(g.z)) * a1[1]); w.w = cvt_pk_bf16(sigm(bflo(g.w)) * a1[2], sigm(bfhi(g.w)) * a1[3]);
                    *(u32x4*)(merged + row * 1024 + col) = w; } }
    }
};

template <int MODE> struct EpiResNorm {
    static constexpr bool PERM = true, AFTER_DRAIN = false; static constexpr int MIDK = 0;
    const float* base; float* xout; const float* gate; float* rowss; unsigned* cnt; const float* nw; const float* mod; bf16_t* h2; unsigned* tmo;
    __device__ __forceinline__ void operator()(f32x4 (&acc)[2][2][4][2], const Unit& u, int wr, int wc, int fr, int fq) const {
        const int row0 = u.pm * BM + wr * 64 + fr, col0 = u.pn * BM + wc * 32 + 8 * fq, b = u.pm >> 3;
        {
            const float* gp = gate + (size_t)b * 6144 + col0;
            f32x4 gv[2][2];
#pragma unroll
            for (int bj = 0; bj < 2; ++bj)
#pragma unroll
                for (int n = 0; n < 2; ++n) gv[bj][n] = *(const f32x4*)(gp + bj * HALF + 4 * n);
#pragma unroll
            for (int ai = 0; ai < 2; ++ai)
#pragma unroll
                for (int m = 0; m < 4; ++m) { const float* bp = base + (size_t)(row0 + ai * HALF + m * 16) * 1024 + col0;
#pragma unroll
                    for (int bj = 0; bj < 2; ++bj)
#pragma unroll
                        for (int n = 0; n < 2; ++n) { const f32x4 bs = *(const f32x4*)(bp + bj * HALF + 4 * n); acc[ai][bj][m][n] = bs + gv[bj][n] * acc[ai][bj][m][n]; }
                    if (m == 3) asm volatile("" : "+v"(acc[ai][0][0][0]), "+v"(acc[ai][0][0][1]), "+v"(acc[ai][1][0][0]), "+v"(acc[ai][1][0][1]),
                                                  "+v"(acc[ai][0][1][0]), "+v"(acc[ai][0][1][1]), "+v"(acc[ai][1][1][0]), "+v"(acc[ai][1][1][1]),
                                                  "+v"(acc[ai][0][2][0]), "+v"(acc[ai][0][2][1]), "+v"(acc[ai][1][2][0]), "+v"(acc[ai][1][2][1]),
                                                  "+v"(acc[ai][0][3][0]), "+v"(acc[ai][0][3][1]), "+v"(acc[ai][1][3][0]), "+v"(acc[ai][1][3][1]) :: "memory"); }
        }
#pragma unroll
        for (int ai = 0; ai < 2; ++ai)
#pragma unroll
            for (int m = 0; m < 4; ++m) { float s = 0.f;
#pragma unroll
                for (int bj = 0; bj < 2; ++bj)
#pragma unroll
                    for (int n = 0; n < 2; ++n) { const f32x4 x = acc[ai][bj][m][n]; s += (x[0] * x[0] + x[1] * x[1]) + (x[2] * x[2] + x[3] * x[3]); }
                s += __shfl_xor(s, 16); s += __shfl_xor(s, 32);
                if (fq == 0) atomicAdd(rowss + row0 + ai * HALF + m * 16, s); }
        asm volatile("s_waitcnt vmcnt(0)" ::: "memory");
        __syncthreads();
        if (threadIdx.x == 0) {
            unsigned* c = cnt + 64 * u.pm;
            __hip_atomic_fetch_add(c, 1u, __ATOMIC_RELAXED, __HIP_MEMORY_SCOPE_AGENT);
            unsigned sp = 0;
            while (__hip_atomic_load(c, __ATOMIC_RELAXED, __HIP_MEMORY_SCOPE_AGENT) < 4u) { __builtin_amdgcn_s_sleep(2); if (++sp > (1u << 22)) { __hip_atomic_store(tmo, 1u, __ATOMIC_RELAXED, __HIP_MEMORY_SCOPE_AGENT); break; } }
            __builtin_amdgcn_fence(__ATOMIC_ACQUIRE, "agent");
            asm volatile("s_waitcnt vmcnt(0)" ::: "memory");
        }
        __syncthreads();
        float rstd[2][4];
#pragma unroll
        for (int ai = 0; ai < 2; ++ai)
#pragma unroll
            for (int m = 0; m < 4; ++m) { const float ss = __hip_atomic_load(rowss + row0 + ai * HALF + m * 16, __ATOMIC_RELAXED, __HIP_MEMORY_SCOPE_AGENT); rstd[ai][m] = rsqrtf(ss * (1.0f / 1024.0f) + 1e-6f); }
        {
            f32x4 scl[2][2], sft[2][2];
#pragma unroll
            for (int bj = 0; bj < 2; ++bj)
#pragma unroll
                for (int n = 0; n < 2; ++n) { const int col = col0 + bj * HALF + 4 * n; scl[bj][n] = *(const f32x4*)(nw + col); sft[bj][n] = (f32x4){0.f, 0.f, 0.f, 0.f};
                    if (MODE == 0) { const f32x4 sc = *(const f32x4*)(mod + (size_t)b * 6144 + 4096 + col); scl[bj][n] = scl[bj][n] * (sc + 1.0f); sft[bj][n] = *(const f32x4*)(mod + (size_t)b * 6144 + 3072 + col); } }
#pragma unroll
            for (int ai = 0; ai < 2; ++ai)
#pragma unroll
                for (int m = 0; m < 4; ++m) { const size_t roff = (size_t)(row0 + ai * HALF + m * 16) * 1024 + col0; const float rs = rstd[ai][m];
#pragma unroll
                    for (int bj = 0; bj < 2; ++bj)
#pragma unroll
                        for (int n = 0; n < 2; ++n) { const size_t off = roff + bj * HALF + 4 * n; const f32x4 v = acc[ai][bj][m][n];
                            if (MODE == 0) { *(f32x4*)(xout + off) = v; const f32x4 y = v * rs * scl[bj][n] + sft[bj][n];
                                u32x2 w; w.x = cvt_pk_bf16(y[0], y[1]); w.y = cvt_pk_bf16(y[2], y[3]); *(u32x2*)(h2 + off) = w; }
                            else *(f32x4*)(xout + off) = v * rs * scl[bj][n]; }
                    asm volatile("" ::: "memory"); }
        }
    }
};
template <class Epi, class Sched, bool ALIGN_EPI = false, bool SP2 = false>
__device__ __forceinline__ void gemm_phase(PG8_LAS unsigned char* lds, const Gemm g, const Sched& S, const Epi& E) {
    int tid_ = threadIdx.x; asm volatile("" : "+v"(tid_));
    const int tid = tid_, wid = __builtin_amdgcn_readfirstlane(tid >> 6), lane = tid & 63, wr = wid >> 2, wc = wid & 3, fr = lane & 15, fq = lane >> 4;
    const int K = g.K, nt = K / BK;
    unsigned voffA[2], voffB[2];
#pragma unroll
    for (int i = 0; i < 2; ++i) { int R, C; stage_rc(tid * 16 + i * 8192, R, C); const int Rb = Epi::PERM ? ((R & ~31) + perm32(R & 31)) : R;
        voffA[i] = (unsigned)(R * K + C) * 2u; voffB[i] = (unsigned)(Rb * K + C) * 2u; }
    const size_t kstep = (size_t)(BK * 2);
    const size_t hstep = (size_t)HALF * K * 2;
    const size_t tstep = 2 * hstep;
    const unsigned ldsw = (unsigned)wid * 1024u;
    const int aoff = lds_byte(wr * 64 + fr, fq * 8), boff = lds_byte(wc * 32 + fr, fq * 8);
#define PG8_SA(b, h) (((b) * 2 + (h)) * HTB)
#define PG8_SB(b, h) ((4 + (b) * 2 + (h)) * HTB)
#define PG8_STAGE(bufoff, gbase, voff) do { _Pragma("unroll") for (int _i = 0; _i < 2; ++_i) \
        __builtin_amdgcn_global_load_lds((const unsigned*)((const char*)(gbase) + (voff)[_i]), (PG8_LAS unsigned*)(lds + (bufoff) + ldsw + _i * 8192), 16, 0, 0); } while (0)
#define PG8_LDA(dst, b, h) do { _Pragma("unroll") for (int m = 0; m < 4; ++m) _Pragma("unroll") for (int k = 0; k < 2; ++k) dst[m][k] = *(const PG8_LAS bf16x8*)(lds + PG8_SA(b, h) + aoff + m * 2048 + k * 1024); } while (0)
#define PG8_LDB(dst, b, h) do { _Pragma("unroll") for (int n = 0; n < 2; ++n) _Pragma("unroll") for (int k = 0; k < 2; ++k) dst[n][k] = *(const PG8_LAS bf16x8*)(lds + PG8_SB(b, h) + boff + n * 2048 + k * 1024); } while (0)
#define PG8_MMA(ai, bj, At, Bt) do { __builtin_amdgcn_s_setprio(1); _Pragma("unroll") for (int m = 0; m < 4; ++m) _Pragma("unroll") for (int n = 0; n < 2; ++n) _Pragma("unroll") for (int k = 0; k < 2; ++k) \
        acc[ai][bj][m][n] = __builtin_amdgcn_mfma_f32_16x16x32_bf16(Bt[n][k], At[m][k], acc[ai][bj][m][n], 0, 0, 0); __builtin_amdgcn_s_setprio(0); } while (0)
#define PG8_WAIT_V(n) asm volatile("s_waitcnt vmcnt(" #n ")" ::: "memory")
#define PG8_WAIT_L(n) asm volatile("s_waitcnt lgkmcnt(" #n ")" ::: "memory")
#define PG8_BAR __builtin_amdgcn_s_barrier()
#define PG8_SCHED __builtin_amdgcn_sched_barrier(0)
    Unit cur, nxt; int ui = 0;
    if (!S.next(0, cur)) return;
    f32x4 acc[2][2][4][2];
#pragma unroll
    for (int a = 0; a < 2; ++a)
#pragma unroll
        for (int b = 0; b < 2; ++b)
#pragma unroll
            for (int m = 0; m < 4; ++m)
#pragma unroll
                for (int n = 0; n < 2; ++n) acc[a][b][m][n] = (f32x4){0.f, 0.f, 0.f, 0.f};
    bf16x8 At[4][2], B0[2][2], B1[2][2];
    const char* cA = (const char*)g.A + (size_t)cur.pm * tstep; const char* cB = (const char*)g.Bt + (size_t)cur.pn * tstep;
    S.a_ready(cur);
    if constexpr (SP2) {
        PG8_STAGE(PG8_SB(0, 0), cB, voffB); PG8_STAGE(PG8_SB(0, 1), cB + hstep, voffB); PG8_STAGE(PG8_SA(0, 0), cA, voffA); PG8_STAGE(PG8_SA(0, 1), cA + hstep, voffA);
        if (wr == 1) PG8_BAR;
        PG8_WAIT_V(2); PG8_BAR;
        PG8_STAGE(PG8_SB(1, 0), cB + kstep, voffB); PG8_STAGE(PG8_SA(1, 0), cA + kstep, voffA); PG8_STAGE(PG8_SB(1, 1), cB + hstep + kstep, voffB);
        PG8_WAIT_V(6); PG8_BAR;
    } else {
        PG8_STAGE(PG8_SB(0, 0), cB, voffB); PG8_STAGE(PG8_SA(0, 0), cA, voffA); PG8_STAGE(PG8_SB(0, 1), cB + hstep, voffB); PG8_STAGE(PG8_SA(0, 1), cA + hstep, voffA);
        if (wr == 1) PG8_BAR;
        PG8_WAIT_V(4); PG8_BAR;
        PG8_STAGE(PG8_SB(1, 0), cB + kstep, voffB); PG8_STAGE(PG8_SA(1, 0), cA + kstep, voffA); PG8_STAGE(PG8_SB(1, 1), cB + hstep + kstep, voffB);
        PG8_WAIT_V(6); PG8_BAR;
    }
    for (;;) {
        const bool has_next = S.next(ui + 1, nxt);
        const char* nA = has_next ? (const char*)g.A + (size_t)nxt.pm * tstep : cA; const char* nB = has_next ? (const char*)g.Bt + (size_t)nxt.pn * tstep : cB;
        for (int t = 0; t < nt; t += 2) {
            if constexpr (Epi::MIDK > 0) { if (t == Epi::MIDK) E.mid(acc, cur, wr, wc, fr, fq); }
            const bool last = (t == nt - 2);
            const char* a1 = cA + (size_t)(t + 1) * kstep;
            const char* a2 = last ? nA : cA + (size_t)(t + 2) * kstep; const char* b2 = last ? nB : cB + (size_t)(t + 2) * kstep;
            const char* a3 = a2 + kstep; const char* b3 = b2 + kstep;
            if (last && has_next) S.a_ready(nxt);
            if constexpr (SP2) {
            PG8_LDB(B0, 0, 0); PG8_LDB(B1, 0, 1); PG8_SCHED; PG8_LDA(At, 0, 0); PG8_STAGE(PG8_SA(1, 1), a1 + hstep, voffA);
            PG8_WAIT_V(8); PG8_WAIT_L(0); PG8_BAR; PG8_MMA(0, 0, At, B0); PG8_MMA(0, 1, At, B1); PG8_BAR; PG8_SCHED;
            PG8_LDA(At, 0, 1); PG8_STAGE(PG8_SB(0, 0), b2, voffB); PG8_STAGE(PG8_SB(0, 1), b2 + hstep, voffB); PG8_STAGE(PG8_SA(0, 0), a2, voffA);
            PG8_WAIT_V(8); PG8_WAIT_L(0); PG8_BAR; PG8_MMA(1, 0, At, B0); PG8_MMA(1, 1, At, B1); PG8_BAR; PG8_SCHED;
            PG8_LDB(B0, 1, 0); PG8_LDB(B1, 1, 1); PG8_SCHED; PG8_LDA(At, 1, 0); PG8_STAGE(PG8_SA(0, 1), a2 + hstep, voffA);
            PG8_WAIT_V(8); PG8_WAIT_L(0); PG8_BAR; PG8_MMA(0, 0, At, B0); PG8_MMA(0, 1, At, B1); PG8_BAR; PG8_SCHED;
            PG8_LDA(At, 1, 1); PG8_STAGE(PG8_SB(1, 0), b3, voffB); PG8_STAGE(PG8_SB(1, 1), b3 + hstep, voffB); PG8_STAGE(PG8_SA(1, 0), a3, voffA);
            PG8_WAIT_V(8); PG8_WAIT_L(0); PG8_BAR; PG8_MMA(1, 0, At, B0); PG8_MMA(1, 1, At, B1); PG8_BAR; PG8_SCHED;
            } else {
            PG8_LDB(B0, 0, 0); PG8_SCHED; PG8_LDA(At, 0, 0); PG8_STAGE(PG8_SA(1, 1), a1 + hstep, voffA);
            PG8_WAIT_L(8); PG8_BAR; PG8_WAIT_L(0); PG8_MMA(0, 0, At, B0); PG8_BAR; PG8_SCHED;
            PG8_LDB(B1, 0, 1); PG8_STAGE(PG8_SB(0, 0), b2, voffB);
            PG8_BAR; PG8_WAIT_L(0); PG8_MMA(0, 1, At, B1); PG8_BAR;
            PG8_LDA(At, 0, 1); PG8_STAGE(PG8_SA(0, 0), a2, voffA);
            PG8_BAR; PG8_WAIT_L(0); PG8_MMA(1, 0, At, B0); PG8_BAR; PG8_SCHED;
            PG8_STAGE(PG8_SB(0, 1), b2 + hstep, voffB);
            PG8_WAIT_V(6); PG8_BAR; PG8_MMA(1, 1, At, B1); PG8_BAR;
            PG8_LDB(B0, 1, 0); PG8_SCHED; PG8_LDA(At, 1, 0); PG8_STAGE(PG8_SA(0, 1), a2 + hstep, voffA);
            PG8_WAIT_L(8); PG8_BAR; PG8_WAIT_L(0); PG8_MMA(0, 0, At, B0); PG8_BAR; PG8_SCHED;
            PG8_LDB(B1, 1, 1); PG8_STAGE(PG8_SB(1, 0), b3, voffB);
            PG8_BAR; PG8_WAIT_L(0); PG8_MMA(0, 1, At, B1); PG8_BAR;
            PG8_LDA(At, 1, 1); PG8_STAGE(PG8_SA(1, 0), a3, voffA);
            PG8_BAR; PG8_WAIT_L(0); PG8_MMA(1, 0, At, B0); PG8_BAR; PG8_SCHED;
            PG8_STAGE(PG8_SB(1, 1), b3 + hstep, voffB);
            PG8_WAIT_V(6); PG8_BAR; PG8_MMA(1, 1, At, B1); PG8_BAR;
            }
        }
        if constexpr (ALIGN_EPI) { if (wr == 0) PG8_BAR; }
        if constexpr (!Epi::AFTER_DRAIN) { E(acc, cur, wr, wc, fr, fq); S.done(cur); }
        if (!has_next) break;
#pragma unroll
        for (int a = 0; a < 2; ++a)
#pragma unroll
            for (int b = 0; b < 2; ++b)
#pragma unroll
                for (int m = 0; m < 4; ++m)
#pragma unroll
                    for (int n = 0; n < 2; ++n) acc[a][b][m][n] = (f32x4){0.f, 0.f, 0.f, 0.f};
        cur = nxt; cA = nA; cB = nB; ++ui;
        if constexpr (ALIGN_EPI) { if (wr == 1) PG8_BAR; }
    }
    PG8_WAIT_V(0);
    if constexpr (!ALIGN_EPI) { if (wr == 0) PG8_BAR; }
    PG8_BAR;
    if constexpr (Epi::AFTER_DRAIN) { E.fused(acc, cur, wr, wc, fr, fq, lds, wid, lane); S.done(cur); }
#undef PG8_SA
#undef PG8_SB
#undef PG8_STAGE
#undef PG8_LDA
#undef PG8_LDB
#undef PG8_MMA
#undef PG8_WAIT_V
#undef PG8_WAIT_L
#undef PG8_BAR
#undef PG8_SCHED
}
}

#define LAS __attribute__((address_space(3)))
typedef unsigned short bf16;
typedef float f32x4 __attribute__((ext_vector_type(4)));
typedef short bf16x8 __attribute__((ext_vector_type(8)));
typedef unsigned u32x4 __attribute__((ext_vector_type(4)));
typedef unsigned u32x2 __attribute__((ext_vector_type(2)));

constexpr int DM = 1024, NB = 16, SEQ = 2048, MTOK = NB * SEQ, CTXL = 256, MCTX = NB * CTXL, MALL = MTOK + MCTX;
constexpr int FFH = 2816, NPROJ = 5376;
constexpr float EPS = 1e-6f;
constexpr size_t MiB = 1u << 20;
constexpr size_t WS_WIN = 1 * MiB, WS_WHP = 12 * MiB, WS_WGP = 13 * MiB, WS_WOUT = 14 * MiB, WS_WFI = 16 * MiB, WS_WFO = 27 * MiB;
constexpr size_t WS_MOD = 16384, WS_ROWSS_A = 448 * 1024, WS_ROWSS_B = 576 * 1024, WS_CNT_A = 704 * 1024, WS_CNT_B = 736 * 1024, WS_TMO = 768 * 1024, WS_ZERO_BYTES = 772 * 1024;
constexpr size_t WS_NP = 41 * MiB, WS_KF = 42 * MiB, WS_KB = 46 * MiB;
constexpr size_t WS_XN = 50 * MiB;
constexpr size_t WS_ZT = 50 * MiB, WS_X0T = 82 * MiB, WS_YGLA = 82 * MiB, WS_H2 = 50 * MiB;
constexpr size_t WS_KVA = 122 * MiB;
constexpr size_t WS_MERGED = 122 * MiB;
constexpr size_t WS_HY = 194 * MiB;
constexpr size_t WS_ACAT = 194 * MiB;
constexpr size_t WS_INTF = 50 * MiB, WS_INTB = 82 * MiB, WS_YT = 122 * MiB, WS_YHY = 50 * MiB;
constexpr size_t WS_QR = 290 * MiB;
constexpr size_t WS_GATES = 338 * MiB;
constexpr size_t WS_INTRA = 466 * MiB;
constexpr size_t WS_UP = 122 * MiB, WS_GATE = 298 * MiB;
constexpr size_t WS_NEED = 498 * MiB;
constexpr size_t DO_UPD = 0, DO_QE = 72 * MiB, DO_GG = 104 * MiB;

constexpr int LDS_BYTES = 139264;

struct Params { const float* in[31]; float* out; unsigned char* ws; };

__device__ __forceinline__ float bf2f(unsigned short h) { return __uint_as_float((unsigned)h << 16); }
__device__ __forceinline__ float bflo(unsigned w) { return __uint_as_float(w << 16); }
__device__ __forceinline__ float bfhi(unsigned w) { return __uint_as_float(w & 0xffff0000u); }
__device__ __forceinline__ unsigned f2bf(float f) { unsigned u = __float_as_uint(f); return (u + 0x7fffu + ((u >> 16) & 1u)) >> 16; }
__device__ __forceinline__ unsigned pk2(float lo, float hi) { unsigned r; asm("v_cvt_pk_bf16_f32 %0, %1, %2" : "=v"(r) : "v"(lo), "v"(hi)); return r; }
__device__ __forceinline__ float wave_sum(float v) {
#pragma unroll
    for (int o = 1; o < 64; o <<= 1) v += __shfl_xor(v, o);
    return v;
}
__device__ __forceinline__ float silu_f(float x) { return x / (1.0f + __expf(-x)); }

__device__ __forceinline__ void transpose_item(const float* W, int K, int N, int src_n0, bf16* WT, int dst_n0, int k0, float* scr, int lane, int kofs = 0) {
    if (src_n0 >= 0) {
        float tv_[32];
#pragma unroll
        for (int i = 0; i < 32; ++i) { const int kk = 2 * i + (lane >> 5); tv_[i] = W[(size_t)(k0 + kk) * N + src_n0 + (lane & 31)]; }
#pragma unroll
        for (int i = 0; i < 32; ++i) { const int kk = 2 * i + (lane >> 5); scr[kk * 33 + (lane & 31)] = tv_[i]; }
    }
    __builtin_amdgcn_wave_barrier();
    const int c = lane & 7;
#pragma unroll
    for (int j = 0; j < 4; ++j) { const int n = (lane >> 3) + 8 * j; const float* s = scr + (8 * c) * 33 + n;
        u32x4 o;
        if (src_n0 >= 0) { o.x = pk2(s[0 * 33], s[1 * 33]); o.y = pk2(s[2 * 33], s[3 * 33]); o.z = pk2(s[4 * 33], s[5 * 33]); o.w = pk2(s[6 * 33], s[7 * 33]); }
        else { o.x = 0; o.y = 0; o.z = 0; o.w = 0; }
        *(u32x4*)(WT + (size_t)(dst_n0 + n) * K + kofs + k0 + 8 * c) = o; }
    __builtin_amdgcn_wave_barrier();
}
__device__ __forceinline__ int win_src(int n0) {
    if (n0 < 256) return 1792 + n0;
    if (n0 < 768) return 2048 + (n0 - 256);
    if (n0 < 800) return 3072 + (n0 - 768);
    if (n0 < 1024) return -1;
    if (n0 < 2560) return n0 - 1024;
    if (n0 < 2816) return 1536 + (n0 - 2560);
    if (n0 < 3328) return 2560 + (n0 - 2816);
    return 3104 + (n0 - 3328);
}

__device__ __forceinline__ void phase0(const Params& P, unsigned char* lds, int G, int bid, int tid, const bool do_ada = true) {
    const int lane = tid & 63, wave = tid >> 6;
    unsigned char* ws = P.ws;
    if (do_ada) {
        float* sl = (float*)lds;
        for (int e = tid; e < 17 * 1024; e += 512) { const int bi = e >> 10, k = e & 1023; const float v = bi < 16 ? P.in[1][bi * 1024 + k] : P.in[3][k]; sl[e] = silu_f(v); }
        __syncthreads();
        const float* wada = P.in[4]; const float* bada = P.in[5]; float* MOD = (float*)(ws + WS_MOD);
        for (int gid = bid * 512 + tid; gid < 6144 * 16; gid += G * 512) {
            const int n = gid % 6144, ks = gid / 6144, k0 = ks * 64;
            float acc[17];
            const float bz = ks == 0 ? bada[n] : 0.f;
#pragma unroll
            for (int bi = 0; bi < 17; ++bi) acc[bi] = bz;
            float w[64];
#pragma unroll
            for (int j = 0; j < 64; ++j) w[j] = wada[(size_t)(k0 + j) * 6144 + n];
#pragma unroll
            for (int kb = 0; kb < 8; ++kb) {
#pragma unroll
                for (int bi = 0; bi < 17; ++bi) { const f32x4 s0 = *(const f32x4*)(sl + bi * 1024 + k0 + 8 * kb), s1 = *(const f32x4*)(sl + bi * 1024 + k0 + 8 * kb + 4);
                    acc[bi] += (s0.x * w[8 * kb] + s0.y * w[8 * kb + 1]) + (s0.z * w[8 * kb + 2] + s0.w * w[8 * kb + 3]) + (s1.x * w[8 * kb + 4] + s1.y * w[8 * kb + 5]) + (s1.z * w[8 * kb + 6] + s1.w * w[8 * kb + 7]); }
                asm volatile("" ::: "memory");
            }
#pragma unroll
            for (int bi = 0; bi < 17; ++bi) atomicAdd(MOD + bi * 6144 + n, acc[bi]);
        }
        __syncthreads();
    }
    {
        float* feats = (float*)lds;
        float* h1 = feats + 8 * 36;
        float* h2 = h1 + 8 * 64;
        const float *w1 = P.in[10], *b1 = P.in[11], *w2 = P.in[12], *b2 = P.in[13], *w3 = P.in[14], *freq = P.in[15], *decay = P.in[16];
        float* KF = (float*)(ws + WS_KF); float* KBk = (float*)(ws + WS_KB); float* NP = (float*)(ws + WS_NP);
        for (int rt = bid; rt < 256; rt += G) {
            const int i0 = rt * 8;
            if (tid < 8 * 33) { const int r = tid / 33, j = tid % 33; const int i = i0 + r;
                const float t = (float)i / 2047.0f, w = 0.0030679615757712823f * (float)i;
                float v;
                if (j == 0) v = t;
                else if (j <= 16) { const float f = 1e-4f + (float)(j - 1) * ((15.0f - 1e-4f) / 15.0f); v = cosf(f * w); }
                else { const float f = 1e-4f + (float)(j - 17) * ((15.0f - 1e-4f) / 15.0f); v = -sinf(f * w); }
                feats[r * 36 + j] = v; }
            __syncthreads();
            { const int r = tid >> 6, m = tid & 63; float s = b1[m]; float wv_[33];
#pragma unroll
              for (int j = 0; j < 33; ++j) wv_[j] = w1[j * 64 + m];
#pragma unroll
              for (int j = 0; j < 33; ++j) s += feats[r * 36 + j] * wv_[j];
              h1[r * 64 + m] = sinf(freq[m] * s); }
            __syncthreads();
            { const int r = tid >> 6, m = tid & 63; float s = b2[m];
#pragma unroll
              for (int j0 = 0; j0 < 64; j0 += 16) { float wv_[16];
#pragma unroll
                  for (int j = 0; j < 16; ++j) wv_[j] = w2[(j0 + j) * 64 + m];
#pragma unroll
                  for (int j = 0; j < 16; ++j) s += h1[r * 64 + j0 + j] * wv_[j]; }
              h2[r * 64 + m] = sinf(freq[m] * s); }
            __syncthreads();
#pragma unroll
            for (int half = 0; half < 2; ++half) {
                const int n = tid + 512 * half;
                float acc[8];
#pragma unroll
                for (int r = 0; r < 8; ++r) acc[r] = 0.f;
#pragma unroll 1
                for (int m0 = 0; m0 < 64; m0 += 8) { float wv_[8];
#pragma unroll
                    for (int j = 0; j < 8; ++j) wv_[j] = w3[(m0 + j) * 1024 + n];
#pragma unroll
                    for (int r = 0; r < 8; ++r) { const f32x4 a = *(const f32x4*)(h2 + r * 64 + m0), b = *(const f32x4*)(h2 + r * 64 + m0 + 4);
                        acc[r] += (a.x * wv_[0] + a.y * wv_[1]) + (a.z * wv_[2] + a.w * wv_[3]) + (b.x * wv_[4] + b.y * wv_[5]) + (b.z * wv_[6] + b.w * wv_[7]); } }
                const float dc = decay[n]; float asum = 0.f;
#pragma unroll
                for (int r = 0; r < 8; ++r) { const int i = i0 + r; const float t = (float)i / 2047.0f; acc[r] *= expf(-t * dc);
                    if (!(half == 1 && i == 0)) asum += fabsf(acc[r]); }
                float* dst = (half == 0 ? KF + (size_t)n * 2048 : KBk + (size_t)(n - 512) * 2048) + i0;
                *(f32x4*)dst = (f32x4){acc[0], acc[1], acc[2], acc[3]}; *(f32x4*)(dst + 4) = (f32x4){acc[4], acc[5], acc[6], acc[7]};
                NP[rt * 1024 + n] = asum;
            }
            __syncthreads();
        }
    }
    {
        float* scr = (float*)(lds + wave * 8704);
        const int gw = bid * 8 + wave, NGW = G * 8;
        constexpr int I_IN = 16 * 168, I_HP = 8 * 32, I_GP = 8 * 32, I_OUT = 16 * 32, I_FI = 16 * 176, I_FO = 44 * 32;
        constexpr int NIT = I_IN + I_HP + I_GP + I_OUT + I_FI + I_FO;
        for (int it = gw; it < NIT; it += NGW) {
            int r = it;
            if (r < I_IN) { const int kb = r / 168, nb = r % 168; transpose_item(P.in[8], 1024, 5152, win_src(32 * nb), (bf16*)(ws + WS_WIN), 32 * nb, 64 * kb, scr, lane); continue; } r -= I_IN;
            if (r < I_HP) { const int kb = r / 32, nb = r % 32; transpose_item(P.in[23], 1024, 1024, 32 * nb, (bf16*)(ws + WS_WHP), 32 * nb, 64 * kb, scr, lane, 0); continue; } r -= I_HP;
            if (r < I_GP) { const int kb = r / 32, nb = r % 32; transpose_item(P.in[24], 1024, 1024, 32 * nb, (bf16*)(ws + WS_WHP), 32 * nb, 64 * kb, scr, lane, 512); continue; } r -= I_GP;
            if (r < I_OUT) { const int kb = r / 32, nb = r % 32; transpose_item(P.in[25], 1024, 1024, 32 * nb, (bf16*)(ws + WS_WOUT), 32 * nb, 64 * kb, scr, lane); continue; } r -= I_OUT;
            if (r < I_FI) { const int kb = r / 176, nb = r % 176; transpose_item(P.in[26], 1024, 5632, 32 * nb, (bf16*)(ws + WS_WFI), 32 * nb, 64 * kb, scr, lane); continue; } r -= I_FI;
            { const int kb = r / 32, nb = r % 32; transpose_item(P.in[29], 2816, 1024, 32 * nb, (bf16*)(ws + WS_WFO), 32 * nb, 64 * kb, scr, lane); }
        }
    }
}

__device__ __forceinline__ void norm_rows2_bf16(const float* xa, const float* xb, bf16* oa, bf16* ob, bool hasb, const float* scl, const float* sft, int lane) {
    const f32x4* xra = (const f32x4*)xa + lane; const f32x4* xrb = (const f32x4*)(hasb ? xb : xa) + lane;
    f32x4 va[4], vb[4]; float sa = 0.f, sb = 0.f;
#pragma unroll
    for (int j = 0; j < 4; ++j) { va[j] = xra[64 * j]; vb[j] = xrb[64 * j]; }
#pragma unroll
    for (int j = 0; j < 4; ++j) { sa += (va[j].x * va[j].x + va[j].y * va[j].y) + (va[j].z * va[j].z + va[j].w * va[j].w);
        sb += (vb[j].x * vb[j].x + vb[j].y * vb[j].y) + (vb[j].z * vb[j].z + vb[j].w * vb[j].w); }
    const float ra = rsqrtf(wave_sum(sa) * (1.f / 1024.f) + EPS), rb = rsqrtf(wave_sum(sb) * (1.f / 1024.f) + EPS);
    unsigned long long* o8a = (unsigned long long*)oa + lane; unsigned long long* o8b = (unsigned long long*)ob + lane;
#pragma unroll
    for (int j = 0; j < 4; ++j) { const f32x4 sc = *((const f32x4*)scl + lane + 64 * j), sf = *((const f32x4*)sft + lane + 64 * j);
        const f32x4 ya = va[j] * ra * sc + sf, yb = vb[j] * rb * sc + sf;
        o8a[64 * j] = (unsigned long long)pk2(ya.x, ya.y) | ((unsigned long long)pk2(ya.z, ya.w) << 32);
        if (hasb) o8b[64 * j] = (unsigned long long)pk2(yb.x, yb.y) | ((unsigned long long)pk2(yb.z, yb.w) << 32); }
}

__device__ __forceinline__ void phase1(const Params& P, unsigned char* lds, int G, int bid, int tid) {
    const int lane = tid & 63, wave = tid >> 6;
    unsigned char* ws = P.ws;
    const float* MOD = (const float*)(ws + WS_MOD);
    float* scl = (float*)lds; float* sft = scl + 1024;
    const int per = (MALL + G - 1) / G; const int r0 = bid * per, r1 = min(MALL, r0 + per);
    int rs = r0;
    while (rs < r1) {
        const int bi = rs < MTOK ? rs / SEQ : 16;
        const int segend = rs < MTOK ? min(r1, (bi + 1) * SEQ) : r1;
        for (int k = tid; k < 1024; k += 512) { scl[k] = P.in[6][k] * (1.0f + MOD[bi * 6144 + 1024 + k]); sft[k] = MOD[bi * 6144 + k]; }
        __syncthreads();
        for (int row = rs + wave; row < segend; row += 16) {
            const int rowb = row + 8; const bool hasb = rowb < segend;
            const float* sa = row < MTOK ? P.in[0] + (size_t)row * 1024 : P.in[2] + (size_t)(row - MTOK) * 1024;
            const float* sb = rowb < MTOK ? P.in[0] + (size_t)rowb * 1024 : P.in[2] + (size_t)(rowb - MTOK) * 1024;
            norm_rows2_bf16(sa, sb, (bf16*)(ws + WS_XN) + (size_t)row * 1024, (bf16*)(ws + WS_XN) + (size_t)rowb * 1024, hasb, scl, sft, lane);
        }
        __syncthreads();
        rs = segend;
    }
}

__device__ __forceinline__ void phase6(const Params& P, unsigned char* lds, int G, int bid, int tid) {
    const int lane = tid & 63, wave = tid >> 6;
    unsigned char* ws = P.ws; const float* MOD = (const float*)(ws + WS_MOD);
    float* scl = (float*)lds; float* sft = scl + 1024;
    const int per = (MTOK + G - 1) / G; const int r0 = bid * per, r1 = min(MTOK, r0 + per);
    int rs = r0;
    while (rs < r1) {
        const int bi = rs / SEQ; const int segend = min(r1, (bi + 1) * SEQ);
        for (int k = tid; k < 1024; k += 512) { scl[k] = P.in[7][k] * (1.0f + MOD[bi * 6144 + 4096 + k]); sft[k] = MOD[bi * 6144 + 3072 + k]; }
        __syncthreads();
        for (int row = rs + wave; row < segend; row += 16) { const int rowb = row + 8;
            norm_rows2_bf16(P.out + (size_t)row * 1024, P.out + (size_t)rowb * 1024, (bf16*)(ws + WS_H2) + (size_t)row * 1024, (bf16*)(ws + WS_H2) + (size_t)rowb * 1024, rowb < segend, scl, sft, lane); }
        __syncthreads();
        rs = segend;
    }
}

__device__ __forceinline__ void phase10(const Params& P, int G, int bid, int tid) {
    const int lane = tid & 63, wave = tid >> 6; const int gw = bid * 8 + wave, NGW = G * 8;
    const float* fw = P.in[30];
    f32x4 wv[4];
#pragma unroll
    for (int j = 0; j < 4; ++j) wv[j] = *((const f32x4*)fw + lane + 64 * j);
    for (int row = gw; row < MTOK; row += 2 * NGW) {
        const int rowb = row + NGW; const bool hasb = rowb < MTOK;
        f32x4* xa = (f32x4*)(P.out + (size_t)row * 1024) + lane; f32x4* xb = (f32x4*)(P.out + (size_t)(hasb ? rowb : row) * 1024) + lane;
        f32x4 va[4], vb[4]; float sa = 0.f, sb = 0.f;
#pragma unroll
        for (int j = 0; j < 4; ++j) { va[j] = xa[64 * j]; vb[j] = xb[64 * j]; }
#pragma unroll
        for (int j = 0; j < 4; ++j) { sa += (va[j].x * va[j].x + va[j].y * va[j].y) + (va[j].z * va[j].z + va[j].w * va[j].w);
            sb += (vb[j].x * vb[j].x + vb[j].y * vb[j].y) + (vb[j].z * vb[j].z + vb[j].w * vb[j].w); }
        const float ra = rsqrtf(wave_sum(sa) * (1.f / 1024.f) + EPS), rb = rsqrtf(wave_sum(sb) * (1.f / 1024.f) + EPS);
#pragma unroll
        for (int j = 0; j < 4; ++j) { xa[64 * j] = va[j] * ra * wv[j]; if (hasb) xb[64 * j] = vb[j] * rb * wv[j]; }
    }
}

__device__ __forceinline__ void hyena_pre(const Params& P, unsigned char* lds, int G, int bid, int tid) {
    unsigned char* ws = P.ws;
    const bf16* HY = (const bf16*)(ws + WS_HY); bf16* ZT = (bf16*)(ws + WS_ZT); bf16* X0T = (bf16*)(ws + WS_X0T);
    bf16* ZL = (bf16*)lds; bf16* XL = ZL + 512 * 66;
    const float* cw = P.in[9];
    const int c = tid;
    float w0[3], w1[3], wv[3];
#pragma unroll
    for (int j = 0; j < 3; ++j) { w0[j] = cw[j * 1536 + c]; w1[j] = cw[j * 1536 + 512 + c]; wv[j] = cw[j * 1536 + 1024 + c]; }
    for (int u = bid; u < 512; u += G) {
        const int b = u >> 5, t0 = (u & 31) * 64;
        const bf16* base = HY + (size_t)b * SEQ * 1536;
        float p0, p1, pv, c0, c1, cv;
        if (t0 > 0) { const bf16* r = base + (size_t)(t0 - 1) * 1536; p0 = bf2f(r[c]); p1 = bf2f(r[512 + c]); pv = bf2f(r[1024 + c]); } else { p0 = p1 = pv = 0.f; }
        { const bf16* r = base + (size_t)t0 * 1536; c0 = bf2f(r[c]); c1 = bf2f(r[512 + c]); cv = bf2f(r[1024 + c]); }
        for (int i0 = 0; i0 < 64; i0 += 8) {
            unsigned short r0[8], r1[8], rv[8];
#pragma unroll
            for (int k = 0; k < 8; ++k) { const int tn = t0 + i0 + k + 1;
                if (tn < SEQ) { const bf16* r = base + (size_t)tn * 1536; r0[k] = r[c]; r1[k] = r[512 + c]; rv[k] = r[1024 + c]; } else { r0[k] = 0; r1[k] = 0; rv[k] = 0; } }
#pragma unroll
            for (int k = 0; k < 8; ++k) {
                const float n0 = bf2f(r0[k]), n1 = bf2f(r1[k]), nv = bf2f(rv[k]);
                const float x0 = w0[0] * p0 + w0[1] * c0 + w0[2] * n0;
                const float x1 = w1[0] * p1 + w1[1] * c1 + w1[2] * n1;
                const float vv = wv[0] * pv + wv[1] * cv + wv[2] * nv;
                ZL[c * 66 + i0 + k] = (bf16)f2bf(x1 * vv); XL[c * 66 + i0 + k] = (bf16)f2bf(x0);
                p0 = c0; p1 = c1; pv = cv; c0 = n0; c1 = n1; cv = nv;
            }
        }
        __syncthreads();
        const unsigned* ZLw = (const unsigned*)ZL; const unsigned* XLw = (const unsigned*)XL;
        for (int it = 0; it < 32; ++it) { const int e = it * 512 + tid, row = e >> 5, w = e & 31;
            const size_t go = ((size_t)(row * 16 + b) * SEQ + t0) / 2 + w;
            ((unsigned*)ZT)[go] = ZLw[row * 33 + w]; ((unsigned*)X0T)[go] = XLw[row * 33 + w]; }
        __syncthreads();
    }
}

__device__ __forceinline__ bf16x8 ldfrag(const bf16* base, int row, int kk, int q) { return *(const bf16x8*)(base + row * 72 + 32 * kk + 8 * q); }

__device__ __forceinline__ void gla_pre(const Params& P, unsigned char* lds, int G, int bid, int tid) {
    unsigned char* ws = P.ws;
    const int lane = tid & 63, wave = tid >> 6, fr = lane & 15, fq = lane >> 4;
    const bf16* KVA = (const bf16*)(ws + WS_KVA); const bf16* QR = (const bf16*)(ws + WS_QR);
    bf16* INTRA = (bf16*)(ws + WS_INTRA);
    bf16* UPD = (bf16*)((unsigned char*)P.out + DO_UPD); bf16* QEG = (bf16*)((unsigned char*)P.out + DO_QE); float* GG = (float*)((unsigned char*)P.out + DO_GG);
    float* bF = (float*)lds; float* bB = bF + 4096;
    bf16* QEF = (bf16*)(lds + 32768); bf16* KEF = QEF + 4608; bf16* QEB = KEF + 4608; bf16* KEB = QEB + 4608;
    bf16* KDTF = KEB + 4608; bf16* KDTB = KDTF + 4608; bf16* VT = KDTB + 4608; bf16* PP = VT + 9216;
    float* tot = (float*)(PP + 4608);
    bf16* AL = (bf16*)(tot + 512);
    u32x4 pa = {0u, 0u, 0u, 0u}, pk = pa, pq = pa, pva = pa, pvb = pa;
#define GLA_PREFETCH(uu) do { const int b_ = (uu) / 144, h_ = ((uu) / 36) & 3, ch_ = (uu) % 36; const bool lat_ = ch_ < 32; \
        const int rb_ = lat_ ? b_ * SEQ + 64 * ch_ : MTOK + b_ * CTXL + 64 * (ch_ - 32); \
        if (tid < 256) pa = *(const u32x4*)(KVA + (size_t)(rb_ + (tid >> 2)) * 1024 + 768 + 8 * (tid & 3)); \
        const size_t row_ = (size_t)(rb_ + (tid >> 3)); const int d0_ = 8 * (tid & 7), v0_ = 16 * (tid & 7); \
        pk = *(const u32x4*)(KVA + row_ * 1024 + h_ * 64 + d0_); \
        if (lat_) pq = *(const u32x4*)(QR + row_ * 768 + h_ * 64 + d0_); \
        pva = *(const u32x4*)(KVA + row_ * 1024 + 256 + h_ * 128 + v0_); pvb = *(const u32x4*)(KVA + row_ * 1024 + 256 + h_ * 128 + v0_ + 8); } while (0)
    if (bid < 16 * 4 * 36) GLA_PREFETCH(bid);
    for (int u = bid; u < 16 * 4 * 36; u += G) {
        const int b = u / 144, h = (u / 36) & 3, ch = u % 36;
        const bool lat = ch < 32;
        const int rowbase = lat ? b * SEQ + 64 * ch : MTOK + b * CTXL + 64 * (ch - 32);
        if (tid < 256) *(u32x4*)(AL + (tid >> 2) * 32 + 8 * (tid & 3)) = pa;
        __syncthreads();
        {
            const int dir = __builtin_amdgcn_readfirstlane(tid >> 8), tg = __builtin_amdgcn_readfirstlane((tid >> 6) & 3), d = tid & 63;
            const float* upw = dir == 0 ? P.in[18] : P.in[20]; const float* ab = dir == 0 ? P.in[19] : P.in[21];
            float up[16];
#pragma unroll
            for (int j = 0; j < 16; ++j) up[j] = upw[j * 256 + h * 64 + d];
            const float bias = ab[h * 64 + d];
            float pre[16]; float run = 0.f;
#pragma unroll
            for (int i = 0; i < 16; ++i) {
                const bf16* ap = AL + (16 * tg + i) * 32 + 16 * dir;
                const u32x4 a0 = *(const u32x4*)ap, a1 = *(const u32x4*)(ap + 8);
                float x = bias;
                x += bflo(a0.x) * up[0] + bfhi(a0.x) * up[1] + bflo(a0.y) * up[2] + bfhi(a0.y) * up[3] + bflo(a0.z) * up[4] + bfhi(a0.z) * up[5] + bflo(a0.w) * up[6] + bfhi(a0.w) * up[7];
                x += bflo(a1.x) * up[8] + bfhi(a1.x) * up[9] + bflo(a1.y) * up[10] + bfhi(a1.y) * up[11] + bflo(a1.z) * up[12] + bfhi(a1.z) * up[13] + bflo(a1.w) * up[14] + bfhi(a1.w) * up[15];
                const float ls = fminf(x, 0.f) - __logf(1.0f + __expf(-fabsf(x)));
                run += ls * (1.0f / 16.0f); pre[i] = run;
            }
            tot[(dir * 4 + tg) * 64 + d] = run;
            __syncthreads();
            float off = 0.f;
            if (dir == 0) { for (int g = 0; g < 4; ++g) if (g < tg) off += tot[g * 64 + d]; }
            else { for (int g = 0; g < 4; ++g) if (g > tg) off += tot[(4 + g) * 64 + d]; }
            if (dir == 0) {
#pragma unroll
                for (int i = 0; i < 16; ++i) bF[(16 * tg + i) * 64 + d] = off + pre[i];
            } else {
#pragma unroll
                for (int i = 0; i < 16; ++i) { const float excl = i == 0 ? 0.f : pre[i - 1]; bB[(16 * tg + i) * 64 + d] = off + (run - excl); }
            }
        }
        __syncthreads();
        {
            const int t = tid >> 3, d0 = 8 * (tid & 7); const size_t row = (size_t)(rowbase + t);
            const u32x4 k8 = pk;
            float kf[8] = {bflo(k8.x), bfhi(k8.x), bflo(k8.y), bfhi(k8.y), bflo(k8.z), bfhi(k8.z), bflo(k8.w), bfhi(k8.w)};
            float qf[8];
            if (lat) { const u32x4 q8 = pq;
                qf[0] = bflo(q8.x); qf[1] = bfhi(q8.x); qf[2] = bflo(q8.y); qf[3] = bfhi(q8.y); qf[4] = bflo(q8.z); qf[5] = bfhi(q8.z); qf[6] = bflo(q8.w); qf[7] = bfhi(q8.w); }
            else {
#pragma unroll
                for (int j = 0; j < 8; ++j) qf[j] = 0.f; }
            float qef[8], kef[8], qeb[8], keb[8];
#pragma unroll
            for (int j = 0; j < 8; ++j) {
                const float f = bF[t * 64 + d0 + j], fl = bF[63 * 64 + d0 + j], bb = bB[t * 64 + d0 + j], b0 = bB[d0 + j];
                const float ef = __expf(f), eb = __expf(bb);
                qef[j] = qf[j] * 0.125f * ef; kef[j] = kf[j] * __expf(-f); qeb[j] = qf[j] * 0.125f * eb; keb[j] = kf[j] * __expf(-bb);
                KDTF[(d0 + j) * 72 + t] = (bf16)f2bf(kf[j] * __expf(fl - f));
                KDTB[(d0 + j) * 72 + t] = (bf16)f2bf(kf[j] * __expf(b0 - bb));
            }
            if (lat) {
                u32x4 w;
                w.x = pk2(qef[0], qef[1]); w.y = pk2(qef[2], qef[3]); w.z = pk2(qef[4], qef[5]); w.w = pk2(qef[6], qef[7]);
                *(u32x4*)(QEF + t * 72 + d0) = w; *(u32x4*)(QEG + ((size_t)((b * 4 + h) * 2 + 0) * 32 + ch) * 4096 + t * 64 + d0) = w;
                w.x = pk2(qeb[0], qeb[1]); w.y = pk2(qeb[2], qeb[3]); w.z = pk2(qeb[4], qeb[5]); w.w = pk2(qeb[6], qeb[7]);
                *(u32x4*)(QEB + t * 72 + d0) = w; *(u32x4*)(QEG + ((size_t)((b * 4 + h) * 2 + 1) * 32 + ch) * 4096 + t * 64 + d0) = w;
                w.x = pk2(kef[0], kef[1]); w.y = pk2(kef[2], kef[3]); w.z = pk2(kef[4], kef[5]); w.w = pk2(kef[6], kef[7]);
                *(u32x4*)(KEF + t * 72 + d0) = w;
                w.x = pk2(keb[0], keb[1]); w.y = pk2(keb[2], keb[3]); w.z = pk2(keb[4], keb[5]); w.w = pk2(keb[6], keb[7]);
                *(u32x4*)(KEB + t * 72 + d0) = w;
            }
            const int v0 = 16 * (tid & 7);
            const u32x4 va = pva, vb = pvb;
            const unsigned vw[8] = {va.x, va.y, va.z, va.w, vb.x, vb.y, vb.z, vb.w};
#pragma unroll
            for (int j = 0; j < 8; ++j) { VT[(v0 + 2 * j) * 72 + t] = (bf16)(vw[j] & 0xffffu); VT[(v0 + 2 * j + 1) * 72 + t] = (bf16)(vw[j] >> 16); }
            if (tid < 128) { const int dir = tid >> 6, d = tid & 63;
                GG[((size_t)((b * 4 + h) * 2 + dir) * 36 + ch) * 64 + d] = dir == 0 ? __expf(bF[63 * 64 + d]) : __expf(bB[d]); }
        }
        __syncthreads();
        if (u + G < 16 * 4 * 36) GLA_PREFETCH(u + G);
        {
            if (lat) {
                const int m = wave >> 1;
#pragma unroll
                for (int nn = 0; nn < 2; ++nn) { const int n = 2 * (wave & 1) + nn;
                    f32x4 af = {0.f, 0.f, 0.f, 0.f}, ab = {0.f, 0.f, 0.f, 0.f};
#pragma unroll
                    for (int kk = 0; kk < 2; ++kk) {
                        af = __builtin_amdgcn_mfma_f32_16x16x32_bf16(ldfrag(QEF, 16 * m + fr, kk, fq), ldfrag(KEF, 16 * n + fr, kk, fq), af, 0, 0, 0);
                        ab = __builtin_amdgcn_mfma_f32_16x16x32_bf16(ldfrag(QEB, 16 * m + fr, kk, fq), ldfrag(KEB, 16 * n + fr, kk, fq), ab, 0, 0, 0); }
                    const int s = 16 * n + fr;
#pragma unroll
                    for (int i = 0; i < 4; ++i) { const int cidx = 16 * m + 4 * fq + i;
                        const float v = (s <= cidx ? af[i] : 0.f) + (s >= cidx ? ab[i] : 0.f);
                        PP[cidx * 72 + s] = (bf16)f2bf(v); }
                }
            }
#pragma unroll
            for (int dir = 0; dir < 2; ++dir) { const bf16* KDT = dir == 0 ? KDTF : KDTB;
                bf16* up = UPD + ((size_t)((b * 4 + h) * 2 + dir) * 36 + ch) * 8192;
                const bf16x8 a0 = ldfrag(VT, 16 * wave + fr, 0, fq), a1 = ldfrag(VT, 16 * wave + fr, 1, fq);
#pragma unroll
                for (int nd = 0; nd < 4; ++nd) {
                    f32x4 acc = {0.f, 0.f, 0.f, 0.f};
                    acc = __builtin_amdgcn_mfma_f32_16x16x32_bf16(a0, ldfrag(KDT, 16 * nd + fr, 0, fq), acc, 0, 0, 0);
                    acc = __builtin_amdgcn_mfma_f32_16x16x32_bf16(a1, ldfrag(KDT, 16 * nd + fr, 1, fq), acc, 0, 0, 0);
#pragma unroll
                    for (int i = 0; i < 4; ++i) up[(16 * wave + 4 * fq + i) * 64 + 16 * nd + fr] = (bf16)f2bf(acc[i]);
                }
            }
        }
        __syncthreads();
        if (lat) {
            const bf16x8 b0 = ldfrag(VT, 16 * wave + fr, 0, fq), b1 = ldfrag(VT, 16 * wave + fr, 1, fq);
#pragma unroll
            for (int m = 0; m < 4; ++m) {
                f32x4 acc = {0.f, 0.f, 0.f, 0.f};
                acc = __builtin_amdgcn_mfma_f32_16x16x32_bf16(ldfrag(PP, 16 * m + fr, 0, fq), b0, acc, 0, 0, 0);
                acc = __builtin_amdgcn_mfma_f32_16x16x32_bf16(ldfrag(PP, 16 * m + fr, 1, fq), b1, acc, 0, 0, 0);
#pragma unroll
                for (int i = 0; i < 4; ++i) INTRA[(size_t)(rowbase + 16 * m + 4 * fq + i) * 512 + h * 128 + 16 * wave + fr] = (bf16)f2bf(acc[i]);
            }
        }
    }
    __syncthreads();
}

struct ScanLd { u32x4 uw[2]; f32x4 gv[2][2]; bf16x8 a[2][2]; };
__device__ __forceinline__ int scan_chunk(int dir, int step) { return dir == 0 ? (step < 4 ? 32 + step : step - 4) : 35 - step; }
__device__ __forceinline__ void scan_load(ScanLd& L, const bf16* UPD, const bf16* QEG, const float* GG, int bh, int dir, int ch, int dvs, int mh, int n, int q) {
    const size_t ud = (size_t)(bh * 2 + dir) * 36 + ch;
#pragma unroll
    for (int kk = 0; kk < 2; ++kk) { L.uw[kk] = *(const u32x4*)(UPD + (ud * 128 + 16 * dvs + n) * 64 + 32 * kk + 8 * q);
        L.gv[kk][0] = *(const f32x4*)(GG + ud * 64 + 32 * kk + 8 * q); L.gv[kk][1] = *(const f32x4*)(GG + ud * 64 + 32 * kk + 8 * q + 4); }
    if (ch < 32) { const bf16* qe = QEG + ((size_t)(bh * 2 + dir) * 32 + ch) * 4096;
#pragma unroll
        for (int mm = 0; mm < 2; ++mm)
#pragma unroll
            for (int kk = 0; kk < 2; ++kk) L.a[mm][kk] = *(const bf16x8*)(qe + (16 * (2 * mh + mm) + n) * 64 + 32 * kk + 8 * q); }
}
__device__ __forceinline__ void gla_scan(const Params& P, int G, int bid, int tid) {
    unsigned char* ws = P.ws;
    const int lane = tid & 63, wave = tid >> 6, n = lane & 15, q = lane >> 4;
    const bf16* UPD = (const bf16*)((unsigned char*)P.out + DO_UPD); const bf16* QEG = (const bf16*)((unsigned char*)P.out + DO_QE); const float* GG = (const float*)((unsigned char*)P.out + DO_GG);
    for (int wu = bid * 8 + wave; wu < 2048; wu += G * 8) {
        const int mh = wu & 1, dvs = (wu >> 1) & 7, dir = (wu >> 4) & 1, bh = wu >> 5, b = bh >> 2, h = bh & 3;
        bf16* INTER = (bf16*)(ws + (dir == 0 ? WS_INTF : WS_INTB));
        float S[2][8];
#pragma unroll
        for (int kk = 0; kk < 2; ++kk)
#pragma unroll
            for (int j = 0; j < 8; ++j) S[kk][j] = 0.f;
        ScanLd L0, L1;
        scan_load(L0, UPD, QEG, GG, bh, dir, scan_chunk(dir, 0), dvs, mh, n, q);
        scan_load(L1, UPD, QEG, GG, bh, dir, scan_chunk(dir, 1), dvs, mh, n, q);
#define SCAN_STEP(LL, st) do { const int ch = scan_chunk(dir, (st)); \
            if (ch < 32) { bf16x8 Bf[2]; \
                _Pragma("unroll") for (int kk = 0; kk < 2; ++kk) { u32x4 w; w.x = pk2(S[kk][0], S[kk][1]); w.y = pk2(S[kk][2], S[kk][3]); w.z = pk2(S[kk][4], S[kk][5]); w.w = pk2(S[kk][6], S[kk][7]); Bf[kk] = __builtin_bit_cast(bf16x8, w); } \
                _Pragma("unroll") for (int mm = 0; mm < 2; ++mm) { const int mt = 2 * mh + mm; f32x4 acc = {0.f, 0.f, 0.f, 0.f}; \
                    _Pragma("unroll") for (int kk = 0; kk < 2; ++kk) acc = __builtin_amdgcn_mfma_f32_16x16x32_bf16(LL.a[mm][kk], Bf[kk], acc, 0, 0, 0); \
                    _Pragma("unroll") for (int i = 0; i < 4; ++i) INTER[(size_t)(b * SEQ + 64 * ch + 16 * mt + 4 * q + i) * 512 + h * 128 + 16 * dvs + n] = (bf16)f2bf(acc[i]); } } \
            _Pragma("unroll") for (int kk = 0; kk < 2; ++kk) { \
                const float uf[8] = {bflo(LL.uw[kk].x), bfhi(LL.uw[kk].x), bflo(LL.uw[kk].y), bfhi(LL.uw[kk].y), bflo(LL.uw[kk].z), bfhi(LL.uw[kk].z), bflo(LL.uw[kk].w), bfhi(LL.uw[kk].w)}; \
                _Pragma("unroll") for (int j = 0; j < 8; ++j) S[kk][j] = LL.gv[kk][j >> 2][j & 3] * S[kk][j] + uf[j]; } \
            if ((st) + 2 < 36) scan_load(LL, UPD, QEG, GG, bh, dir, scan_chunk(dir, (st) + 2), dvs, mh, n, q); } while (0)
        for (int step = 0; step < 36; step += 2) { SCAN_STEP(L0, step); SCAN_STEP(L1, step + 1); }
#undef SCAN_STEP
    }
}

constexpr int RLEN = 4112, ZPITCH = 2056;
__device__ __forceinline__ void toeplitz(const Params& P, unsigned char* lds, int G, int bid, int tid) {
    unsigned char* ws = P.ws;
    const int lane = tid & 63, wave = tid >> 6, fr = lane & 15, fq = lane >> 4;
    const float* KF = (const float*)(ws + WS_KF); const float* KBk = (const float*)(ws + WS_KB); const float* NP = (const float*)(ws + WS_NP);
    const bf16* HYT = (const bf16*)(ws + WS_HY); bf16* YTo = (bf16*)(ws + WS_YT); const float* cw = P.in[9];
    bf16* R = (bf16*)lds;
    bf16* ZL = R + 8 * RLEN;
    float* red = (float*)(ZL + 16 * ZPITCH);
    for (int c = bid; c < 512; c += G) {
        float pv = 0.f;
        if (tid < 256) pv = NP[tid * 1024 + c] + NP[tid * 1024 + 512 + c];
        pv = wave_sum(pv);
        if (lane == 0) red[wave] = pv;
        float* C = (float*)ZL;
        { const f32x4 f = *(const f32x4*)(KF + (size_t)c * 2048 + 4 * tid), g = *(const f32x4*)(KBk + (size_t)c * 2048 + 4 * tid);
          *(f32x4*)(C + 2048 + 4 * tid) = f;
          if (tid > 0) C[2048 - 4 * tid] = g.x; else C[0] = 0.f;
          C[2047 - 4 * tid] = g.y; C[2046 - 4 * tid] = g.z; C[2045 - 4 * tid] = g.w; }
        __syncthreads();
        const float rnorm = 1.0f / (red[0] + red[1] + red[2] + red[3]);
        for (int e = tid; e < 8 * 514; e += 512) { const int o = e / 514, mg = e - o * 514; const int i0 = o + 4096 - 8 * mg;
            float v[8];
#pragma unroll
            for (int j = 0; j < 8; ++j) { const int idx = i0 - j; v[j] = (idx >= 0 && idx < 4096) ? C[idx] * rnorm : 0.f; }
            u32x4 w; w.x = pk2(v[0], v[1]); w.y = pk2(v[2], v[3]); w.z = pk2(v[4], v[5]); w.w = pk2(v[6], v[7]);
            *(u32x4*)(R + o * RLEN + 8 * mg) = w; }
        __syncthreads();
        {
            const float a0 = cw[512 + c], a1 = cw[1536 + 512 + c], a2 = cw[3072 + 512 + c], v0 = cw[1024 + c], v1 = cw[1536 + 1024 + c], v2 = cw[3072 + 1024 + c];
            const bf16* x1r = HYT + (size_t)(512 + c) * 32768; const bf16* vr = HYT + (size_t)(1024 + c) * 32768;
#pragma unroll 2
            for (int it = 0; it < 8; ++it) { const int e = it * 512 + tid, b = e >> 8, off = (e & 255) * 8; const size_t go = (size_t)b * SEQ + off;
                const u32x4 xa = *(const u32x4*)(x1r + go), va = *(const u32x4*)(vr + go);
                const float xlo = off > 0 ? bf2f(x1r[go - 1]) : 0.f, xhi = off + 8 < SEQ ? bf2f(x1r[go + 8]) : 0.f;
                const float vlo = off > 0 ? bf2f(vr[go - 1]) : 0.f, vhi = off + 8 < SEQ ? bf2f(vr[go + 8]) : 0.f;
                const float xs[10] = {xlo, bflo(xa.x), bfhi(xa.x), bflo(xa.y), bfhi(xa.y), bflo(xa.z), bfhi(xa.z), bflo(xa.w), bfhi(xa.w), xhi};
                const float vs[10] = {vlo, bflo(va.x), bfhi(va.x), bflo(va.y), bfhi(va.y), bflo(va.z), bfhi(va.z), bflo(va.w), bfhi(va.w), vhi};
                float z[8];
#pragma unroll
                for (int k = 0; k < 8; ++k) z[k] = (a0 * xs[k] + a1 * xs[k + 1] + a2 * xs[k + 2]) * (v0 * vs[k] + v1 * vs[k + 1] + v2 * vs[k + 2]);
                u32x4 w; w.x = pk2(z[0], z[1]); w.y = pk2(z[2], z[3]); w.z = pk2(z[4], z[5]); w.w = pk2(z[6], z[7]);
                *(u32x4*)(ZL + b * ZPITCH + off) = w; }
        }
        __syncthreads();
        f32x4 acc[16];
#pragma unroll
        for (int i = 0; i < 16; ++i) acc[i] = (f32x4){0.f, 0.f, 0.f, 0.f};
        const bf16* abase = R + wave * RLEN + 2048 - 8 * (fr - fq);
        const bf16* bbase = ZL + fr * ZPITCH + 8 * fq;
        for (int jr = 0; jr < 4; ++jr) {
            bf16x8 W[16];
#pragma unroll
            for (int dl = 0; dl < 16; ++dl) W[dl] = *(const bf16x8*)(abase - (128 * dl - 32 * jr));
#pragma unroll
            for (int jq = 0; jq < 16; ++jq) {
                if (jq > 0) W[(16 - jq) & 15] = *(const bf16x8*)(abase - (-128 * jq - 32 * jr));
                const bf16x8 Bv = *(const bf16x8*)(bbase + 32 * (4 * jq + jr));
#pragma unroll
                for (int i = 0; i < 16; ++i) acc[i] = __builtin_amdgcn_mfma_f32_16x16x32_bf16(W[(i - jq) & 15], Bv, acc[i], 0, 0, 0);
            }
        }
        __syncthreads();
        const float hb = P.in[17][c];
#pragma unroll
        for (int i = 0; i < 16; ++i)
#pragma unroll
            for (int ii = 0; ii < 4; ++ii) { const int t = 128 * i + wave + 8 * (4 * fq + ii); bf16* zp = ZL + fr * ZPITCH + t;
                *zp = (bf16)f2bf(acc[i][ii] + hb * bf2f(*zp)); }
        __syncthreads();
        {
            const float a0 = cw[c], a1 = cw[1536 + c], a2 = cw[3072 + c];
            const bf16* x0r = HYT + (size_t)c * 32768;
#pragma unroll 2
            for (int it = 0; it < 8; ++it) { const int e = it * 512 + tid, b = e >> 8, off = (e & 255) * 8; const size_t go = (size_t)b * SEQ + off;
                const u32x4 y = *(const u32x4*)(ZL + b * ZPITCH + off), xa = *(const u32x4*)(x0r + go);
                const float xlo = off > 0 ? bf2f(x0r[go - 1]) : 0.f, xhi = off + 8 < SEQ ? bf2f(x0r[go + 8]) : 0.f;
                const float xs[10] = {xlo, bflo(xa.x), bfhi(xa.x), bflo(xa.y), bfhi(xa.y), bflo(xa.z), bfhi(xa.z), bflo(xa.w), bfhi(xa.w), xhi};
                const float ys[8] = {bflo(y.x), bfhi(y.x), bflo(y.y), bfhi(y.y), bflo(y.z), bfhi(y.z), bflo(y.w), bfhi(y.w)};
                float o[8];
#pragma unroll
                for (int k = 0; k < 8; ++k) o[k] = ys[k] * (a0 * xs[k] + a1 * xs[k + 1] + a2 * xs[k + 2]);
                u32x4 w; w.x = pk2(o[0], o[1]); w.y = pk2(o[2], o[3]); w.z = pk2(o[4], o[5]); w.w = pk2(o[6], o[7]);
                *(u32x4*)(YTo + ((size_t)c * 16 + b) * SEQ + off) = w; }
        }
        __syncthreads();
    }
}

__device__ __forceinline__ void mixer_post(const Params& P, unsigned char* lds, int G, int bid, int tid) {
    unsigned char* ws = P.ws;
    const int lane = tid & 63, wave = tid >> 6;
    const bf16* YT = (const bf16*)(ws + WS_YT); bf16* YHY = (bf16*)(ws + WS_ACAT);
    unsigned* YLw = (unsigned*)lds;
    for (int u = bid; u < 512; u += G) {
        const int b = u >> 5, t0 = (u & 31) * 64;
        for (int it = 0; it < 32; ++it) { const int e = it * 512 + tid, row = e >> 5, w = e & 31;
            YLw[row * 33 + w] = ((const unsigned*)YT)[((size_t)(row * 16 + b) * SEQ + t0) / 2 + w]; }
        __syncthreads();
        const bf16* YL = (const bf16*)YLw;
        for (int i = 0; i < 64; ++i) YHY[(size_t)(b * SEQ + t0 + i) * 1024 + tid] = YL[tid * 66 + i];
        __syncthreads();
    }
    const bf16* INTRA = (const bf16*)(ws + WS_INTRA); const bf16* INTF = (const bf16*)(ws + WS_INTF); const bf16* INTB = (const bf16*)(ws + WS_INTB);
    const bf16* QR = (const bf16*)(ws + WS_QR); bf16* YGLA = (bf16*)(ws + WS_ACAT) + 512;
    const float* gw_ = P.in[22];
    const f32x4 nw0 = *(const f32x4*)(gw_ + 8 * lane), nw1 = *(const f32x4*)(gw_ + 8 * lane + 4);
    const float nw[8] = {nw0.x, nw0.y, nw0.z, nw0.w, nw1.x, nw1.y, nw1.z, nw1.w};
    for (int m = bid * 8 + wave; m < MTOK; m += G * 8) {
        const size_t o8 = (size_t)m * 512 + 8 * lane;
        const u32x4 a = *(const u32x4*)(INTRA + o8), f = *(const u32x4*)(INTF + o8), g = *(const u32x4*)(INTB + o8), r = *(const u32x4*)(QR + (size_t)m * 768 + 256 + 8 * lane);
        float o[8] = {bflo(a.x) + bflo(f.x) + bflo(g.x), bfhi(a.x) + bfhi(f.x) + bfhi(g.x), bflo(a.y) + bflo(f.y) + bflo(g.y), bfhi(a.y) + bfhi(f.y) + bfhi(g.y),
                      bflo(a.z) + bflo(f.z) + bflo(g.z), bfhi(a.z) + bfhi(f.z) + bfhi(g.z), bflo(a.w) + bflo(f.w) + bflo(g.w), bfhi(a.w) + bfhi(f.w) + bfhi(g.w)};
        const float rr[8] = {bflo(r.x), bfhi(r.x), bflo(r.y), bfhi(r.y), bflo(r.z), bfhi(r.z), bflo(r.w), bfhi(r.w)};
        float ss = 0.f;
#pragma unroll
        for (int j = 0; j < 8; ++j) ss += o[j] * o[j];
        ss += __shfl_xor(ss, 1); ss += __shfl_xor(ss, 2); ss += __shfl_xor(ss, 4); ss += __shfl_xor(ss, 8);
        const float rstd = rsqrtf(ss * (1.f / 128.f) + EPS);
        float y[8];
#pragma unroll
        for (int j = 0; j < 8; ++j) y[j] = o[j] * rstd * nw[j] * silu_f(rr[j]);
        u32x4 w; w.x = pk2(y[0], y[1]); w.y = pk2(y[2], y[3]); w.z = pk2(y[4], y[5]); w.w = pk2(y[6], y[7]);
        *(u32x4*)(YGLA + (size_t)m * 1024 + 8 * lane) = w;
    }
}

typedef float f32x2 __attribute__((ext_vector_type(2)));
struct G8 { f32x2 v[4]; };
__device__ __forceinline__ u32x4 ldg_mask(const bf16* p, bool ok) { u32x4 g = {0u, 0u, 0u, 0u}; if (ok) g = *(const u32x4*)p; return g; }
__device__ __forceinline__ G8 unpack8(const u32x4 g) { G8 r; r.v[0] = (f32x2){bflo(g.x), bfhi(g.x)}; r.v[1] = (f32x2){bflo(g.y), bfhi(g.y)}; r.v[2] = (f32x2){bflo(g.z), bfhi(g.z)}; r.v[3] = (f32x2){bflo(g.w), bfhi(g.w)}; return r; }
__device__ __forceinline__ void dwconv(const Params& P, int G, int bid, int tid, const bool real = true) {
    unsigned char* ws = P.ws;
    const int lane = tid & 63, wave = tid >> 6;
    const bf16* GATE = (const bf16*)(ws + WS_GATE); bf16* UP = (bf16*)(ws + WS_UP);
    const float* dw = P.in[27]; const float* dwb = P.in[28];
    const int gw = bid * 8 + wave, NGW = G * 8, nper = NGW / 11;
    if (gw >= nper * 11) return;
    const int cb = gw % 11, k0 = gw / 11;
    const int x0 = 32 * (lane >> 5), c0 = cb * 256 + (lane & 31) * 8;
    f32x2 wt[9][4], bs[4];
#pragma unroll
    for (int tp = 0; tp < 9; ++tp) { const f32x4 a = *(const f32x4*)(dw + tp * FFH + c0), b = *(const f32x4*)(dw + tp * FFH + c0 + 4);
        wt[tp][0] = (f32x2){a.x, a.y}; wt[tp][1] = (f32x2){a.z, a.w}; wt[tp][2] = (f32x2){b.x, b.y}; wt[tp][3] = (f32x2){b.z, b.w}; }
    { const f32x4 a = *(const f32x4*)(dwb + c0), b = *(const f32x4*)(dwb + c0 + 4); bs[0] = (f32x2){a.x, a.y}; bs[1] = (f32x2){a.z, a.w}; bs[2] = (f32x2){b.x, b.y}; bs[3] = (f32x2){b.z, b.w}; }
    for (int rowid = k0; rowid < 512; rowid += nper) {
        const int b = rowid >> 5, y = rowid & 31;
        const bf16* grow[3]; bool rok[3];
#pragma unroll
        for (int d = 0; d < 3; ++d) { const int yy = y + d - 1; rok[d] = yy >= 0 && yy <= 31; grow[d] = GATE + (size_t)(b * SEQ + (rok[d] ? yy : y) * 64) * FFH + c0; }
        bf16* urow = UP + (size_t)(b * SEQ + y * 64) * FFH + c0;
        G8 prv[3], cur[3];
#pragma unroll
        for (int d = 0; d < 3; ++d) { prv[d] = unpack8(ldg_mask(grow[d] + (size_t)(x0 - 1) * FFH, rok[d] && x0 > 0)); cur[d] = unpack8(ldg_mask(grow[d] + (size_t)x0 * FFH, rok[d])); }
        for (int xs = 0; xs < 32; xs += 2) {
            u32x4 nraw[2][3], uv[2];
#pragma unroll
            for (int k = 0; k < 2; ++k) { const int xn = x0 + xs + k + 1;
#pragma unroll
                for (int d = 0; d < 3; ++d) nraw[k][d] = ldg_mask(grow[d] + (size_t)xn * FFH, rok[d] && xn <= 63);
                uv[k] = *(const u32x4*)(urow + (size_t)(x0 + xs + k) * FFH); }
#pragma unroll
            for (int k = 0; k < 2; ++k) {
                G8 nxt[3];
#pragma unroll
                for (int d = 0; d < 3; ++d) nxt[d] = unpack8(nraw[k][d]);
                f32x2 acc[4];
#pragma unroll
                for (int j = 0; j < 4; ++j) acc[j] = bs[j];
#pragma unroll
                for (int d = 0; d < 3; ++d)
#pragma unroll
                    for (int j = 0; j < 4; ++j) acc[j] += prv[d].v[j] * wt[d * 3 + 0][j] + cur[d].v[j] * wt[d * 3 + 1][j] + nxt[d].v[j] * wt[d * 3 + 2][j];
                const G8 u8 = unpack8(uv[k]);
                unsigned wv[4];
#pragma unroll
                for (int j = 0; j < 4; ++j) { const float e0 = __expf(-acc[j].x), e1 = __expf(-acc[j].y);
                    const float s0 = acc[j].x * __builtin_amdgcn_rcpf(1.0f + e0), s1 = acc[j].y * __builtin_amdgcn_rcpf(1.0f + e1);
                    wv[j] = pk2(s0 * u8.v[j].x, s1 * u8.v[j].y); }
                u32x4 w; w.x = wv[0]; w.y = wv[1]; w.z = wv[2]; w.w = wv[3];
                if (real || (w.x == 0x12345678u && w.y == 0x9abcdef0u)) *(u32x4*)(urow + (size_t)(x0 + xs + k) * FFH) = w;
#pragma unroll
                for (int d = 0; d < 3; ++d) { prv[d] = cur[d]; cur[d] = nxt[d]; }
            }
        }
    }
}

#define XB_TMO      128
#define XB_XCNT(j)  (256  + 64 * (j))
#define XB_XSUB(j)  (1280 + 64 * (j))
#define XB_XGEN(j)  (2304 + 64 * (j))
#define XB_TOP      3328
#define XB_TOPGEN   3392
#define XCD_BAR_WORDS 3456
#define XB_SPIN_CAP (1u << 18)

__device__ __forceinline__ unsigned xb_ld(unsigned* p)              { return __hip_atomic_load(p, __ATOMIC_RELAXED, __HIP_MEMORY_SCOPE_AGENT); }
__device__ __forceinline__ unsigned xb_add(unsigned* p, unsigned v) { return __hip_atomic_fetch_add(p, v, __ATOMIC_RELAXED, __HIP_MEMORY_SCOPE_AGENT); }
__device__ __forceinline__ unsigned xb_xcc_id() { return (unsigned)__builtin_amdgcn_s_getreg((3 << 11) | 20) & 0xFu; }
#define XB_SPIN(cond, bar) do { unsigned _sp = 0; while (cond) { __builtin_amdgcn_s_sleep(1); \
    if ((++_sp & 255u) == 0u) { if (xb_ld(&(bar)[XB_TMO])) break; if (_sp > XB_SPIN_CAP) { atomicAdd(&(bar)[XB_TMO], 1u); break; } } } } while (0)

struct XcdBarrier {
    unsigned* bar; unsigned x;
    volatile LAS unsigned* st;
};

__device__ __forceinline__ XcdBarrier xcd_barrier_post(unsigned* bar, volatile LAS unsigned* st) {
    XcdBarrier b; b.bar = bar; b.x = xb_xcc_id(); b.st = st;
    if (threadIdx.x == 0) (void)xb_add(&bar[XB_XCNT(b.x)], 1u);
    return b;
}
__device__ __forceinline__ void xcd_barrier_complete(unsigned* bar, unsigned x, unsigned& nloc, unsigned& nx) {
    const unsigned G = gridDim.x * gridDim.y * gridDim.z;
    unsigned sum, cnt, mine, sp = 0u;
    for (;;) {
        sum = 0u; cnt = 0u; mine = 0u;
#pragma unroll
        for (unsigned j = 0; j < 16; ++j) { const unsigned c = xb_ld(&bar[XB_XCNT(j)]); sum += c; cnt += (c > 0u) ? 1u : 0u; mine = (j == x) ? c : mine; }
        if (sum == G) break;
        __builtin_amdgcn_s_sleep(1);
        if ((++sp & 255u) == 0u) { if (xb_ld(&bar[XB_TMO])) break; if (sp > XB_SPIN_CAP) { atomicAdd(&bar[XB_TMO], 1u); break; } }
    }
    nloc = mine > 0u ? mine : 1u; nx = cnt > 0u ? cnt : 1u;
}

__device__ __forceinline__ void xcd_barrier(const XcdBarrier& b) {
    asm volatile("s_waitcnt vmcnt(0)" ::: "memory");
    __syncthreads();
    if (threadIdx.x == 0) {
        unsigned* bar = b.bar;
        __builtin_amdgcn_s_waitcnt(0);
        unsigned nloc = b.st[0], nx = b.st[1];
        if (nloc == 0u) { xcd_barrier_complete(bar, b.x, nloc, nx); b.st[0] = nloc; b.st[1] = nx; }
        const unsigned old = xb_add(&bar[XB_XSUB(b.x)], 1u);
        const unsigned gen = old / nloc;
        if (old + 1u == (gen + 1u) * nloc) {
            __builtin_amdgcn_fence(__ATOMIC_RELEASE, "agent");
            asm volatile("s_waitcnt vmcnt(0)" ::: "memory");
            const unsigned og = xb_add(&bar[XB_TOP], 1u);
            const unsigned tg = og / nx;
            if (og + 1u == (tg + 1u) * nx) xb_add(&bar[XB_TOPGEN], 1u);
            else XB_SPIN(xb_ld(&bar[XB_TOPGEN]) == tg, bar);
            __builtin_amdgcn_fence(__ATOMIC_ACQUIRE, "agent");
            xb_add(&bar[XB_XGEN(b.x)], 1u);
            asm volatile("s_waitcnt vmcnt(0)" ::: "memory");
        } else {
            XB_SPIN(xb_ld(&bar[XB_XGEN(b.x)]) == gen, bar);
            __builtin_amdgcn_fence(__ATOMIC_ACQUIRE, "agent");
            asm volatile("s_waitcnt vmcnt(0)" ::: "memory");
        }
    }
    __syncthreads();
}

__global__ void __launch_bounds__(512, 2) fwd_megakernel(Params P) {
    extern __shared__ __attribute__((aligned(16))) unsigned char lds[];
    cg::grid_group grid = cg::this_grid();
    const int G = gridDim.x, bid = blockIdx.x, tid = threadIdx.x;
    unsigned char* ws = P.ws;
    PG8_LAS unsigned char* glds = (PG8_LAS unsigned char*)lds;
    volatile LAS unsigned* bst = (volatile LAS unsigned*)(glds + LDS_BYTES - 16);
    if (tid < 4) bst[tid] = 0u;
    __syncthreads();
    XcdBarrier xb = xcd_barrier_post((unsigned*)ws, bst);
#define GSYNC() xcd_barrier(xb)

    phase0(P, lds, G, bid, tid);
    if (P.ws == nullptr) grid.sync();
    GSYNC();
    phase1(P, lds, G, bid, tid);
    GSYNC();
    {
        pg8::Gemm g{(const pg8::bf16_t*)(ws + WS_XN), (const pg8::bf16_t*)(ws + WS_WIN), MALL, NPROJ, 1024};
        pg8::ProjOrder S; S.init(G, bid);
        pg8::EpiProj E{(pg8::bf16_t*)(ws + WS_KVA), (pg8::bf16_t*)(ws + WS_HY), (pg8::bf16_t*)(ws + WS_QR), (pg8::bf16_t*)(ws + WS_GATES)};
        pg8::gemm_phase<pg8::EpiProj, pg8::ProjOrder, true, true>(glds, g, S, E);
    }
    GSYNC();
    gla_pre(P, lds, G, bid, tid);
    GSYNC();
    gla_scan(P, G, bid, tid);
    toeplitz(P, lds, G, bid, tid);
    GSYNC();
    mixer_post(P, lds, G, bid, tid);
    GSYNC();
    {
        pg8::StaticOrder S; S.init(MTOK, 1024, G, bid);
        pg8::Gemm g{(const pg8::bf16_t*)(ws + WS_ACAT), (const pg8::bf16_t*)(ws + WS_WHP), MTOK, 1024, 1024};
        pg8::EpiGateFused E{(const pg8::bf16_t*)(ws + WS_GATES), (pg8::bf16_t*)(ws + WS_MERGED)};
        pg8::gemm_phase<pg8::EpiGateFused, pg8::StaticOrder, true, true>(glds, g, S, E);
    }
    GSYNC();
    {
        pg8::StaticOrder S; S.init(MTOK, 1024, G, bid);
        pg8::Gemm g{(const pg8::bf16_t*)(ws + WS_MERGED), (const pg8::bf16_t*)(ws + WS_WOUT), MTOK, 1024, 1024};
        pg8::EpiResNorm<0> E{P.in[0], P.out, (const float*)(ws + WS_MOD) + 2048, (float*)(ws + WS_ROWSS_A), (unsigned*)(ws + WS_CNT_A), P.in[7], (const float*)(ws + WS_MOD), (pg8::bf16_t*)(ws + WS_H2), (unsigned*)(ws + WS_TMO)};
        pg8::gemm_phase<pg8::EpiResNorm<0>, pg8::StaticOrder, true, true>(glds, g, S, E);
    }
    GSYNC();
    {
        pg8::StaticOrder S; S.init(MTOK, 2 * FFH, G, bid);
        pg8::Gemm g{(const pg8::bf16_t*)(ws + WS_H2), (const pg8::bf16_t*)(ws + WS_WFI), MTOK, 2 * FFH, 1024};
        pg8::EpiSplit E{(pg8::bf16_t*)(ws + WS_UP), (pg8::bf16_t*)(ws + WS_GATE), 11, FFH};
        pg8::gemm_phase<pg8::EpiSplit, pg8::StaticOrder, true, true>(glds, g, S, E);
    }
    GSYNC();
    dwconv(P, G, bid, tid);
    GSYNC();
    {
        pg8::StaticOrder S; S.init(MTOK, 1024, G, bid);
        pg8::Gemm g{(const pg8::bf16_t*)(ws + WS_UP), (const pg8::bf16_t*)(ws + WS_WFO), MTOK, 1024, FFH};
        pg8::EpiResNorm<1> E{P.out, P.out, (const float*)(ws + WS_MOD) + 5120, (float*)(ws + WS_ROWSS_B), (unsigned*)(ws + WS_CNT_B), P.in[30], (const float*)(ws + WS_MOD), nullptr, (unsigned*)(ws + WS_TMO)};
        pg8::gemm_phase<pg8::EpiResNorm<1>, pg8::StaticOrder, true, true>(glds, g, S, E);
    }
}

extern "C" void kernel_launch(void* const* d_in, const int* in_sizes, int n_in, void* d_out, int out_size, void* d_ws, size_t ws_size, hipStream_t stream) {
    static int grid = 0;
    if (grid == 0) {
        if (n_in != 31 || out_size != MTOK * DM || ws_size < WS_NEED) { fprintf(stderr, "kernel_launch: unexpected shapes: n_in %d out %d ws %zu (need %zu)\n", n_in, out_size, ws_size, (size_t)WS_NEED); grid = -1; return; }
        int dev = 0, cus = 0, per_cu = 0;
        hipGetDevice(&dev);
        hipDeviceGetAttribute(&cus, hipDeviceAttributeMultiprocessorCount, dev);
        if (hipFuncSetAttribute((const void*)fwd_megakernel, hipFuncAttributeMaxDynamicSharedMemorySize, LDS_BYTES) != hipSuccess) { fprintf(stderr, "kernel_launch: hipFuncSetAttribute failed\n"); grid = -1; return; }
        if (hipOccupancyMaxActiveBlocksPerMultiprocessor(&per_cu, (const void*)fwd_megakernel, 512, LDS_BYTES) != hipSuccess || per_cu < 1) { fprintf(stderr, "kernel_launch: occupancy query failed (%d)\n", per_cu); per_cu = 1; }
        (void)hipGetLastError();
        grid = cus * 1;
        fprintf(stderr, "kernel_launch: cus %d per_cu %d grid %d\n", cus, per_cu, grid);
    }
    if (grid < 0) return;
    Params p{};
    for (int i = 0; i < 31; ++i) p.in[i] = (const float*)d_in[i];
    p.out = (float*)d_out; p.ws = (unsigned char*)d_ws;
    if (hipMemsetAsync(d_ws, 0, WS_ZERO_BYTES, stream) != hipSuccess) { fprintf(stderr, "kernel_launch: memset failed\n"); return; }
    void* args[] = {&p};
    hipError_t e = hipLaunchCooperativeKernel((const void*)fwd_megakernel, dim3(grid), dim3(512), args, LDS_BYTES, stream);
    if (e != hipSuccess) fprintf(stderr, "kernel_launch: cooperative launch failed: %s (grid %d)\n", hipGetErrorString(e), grid);
}
```
